# Optimizing an MI355X kernel written in HIP

```python
import math
import jax, jax.numpy as jnp
from jax import lax
import numpy as np

D_MODEL = 1024
BATCH = 16
SEQ = 256
DEPTH = 2
DEC_BATCH = 8
DEC_SEQ = 4096
PAST_LEN = 512

GRID_W = 64
D_MIX = D_MODEL
C_CONV = D_MIX // 4
CONV_WIDTH = 31
H_GLA = 4
DK_GLA = 64
DV_GLA = 64
W_GLA = H_GLA * DV_GLA
GLA_RANK = 16
GLA_TAU = 16.0
GLA_CHUNK = 64
H_DIFF = 4
DH_DIFF = 64
DV_DIFF = 2 * DH_DIFF
W_DIFF = H_DIFF * DV_DIFF
Q_BLOCK = 128
ROPE_BASE = 10000.0
IN_CONV = 2 * C_CONV
IN_GLA = 4 * W_GLA + 2 * GLA_RANK
IN_DIFF = 3 * W_DIFF
IN_COLS = IN_CONV + IN_GLA + IN_DIFF
D_FF = 2816
ALPHA = (2 * DEPTH) ** 0.25
BETA = (8 * DEPTH) ** -0.25
LN_EPS = 1e-5
N_MOD = 9

kernel_name = 'hybrid_dit_conv_gla_diffattn_step'


def layer_norm(x, g, b):
    xf = x.astype(jnp.float32)
    mu = jnp.mean(xf, axis=-1, keepdims=True)
    var = jnp.mean(jnp.square(xf - mu), axis=-1, keepdims=True)
    y = (xf - mu) * lax.rsqrt(var + LN_EPS)
    return (y * g.astype(jnp.float32) + b.astype(jnp.float32)).astype(x.dtype)


def rms_norm(x, g):
    xf = x.astype(jnp.float32)
    y = xf * lax.rsqrt(jnp.mean(jnp.square(xf), axis=-1, keepdims=True) + LN_EPS)
    return (y * g.astype(jnp.float32)).astype(x.dtype)


def swiglu_ffn(h, w_in, w_out):
    a, b = jnp.split(h @ w_in, 2, axis=-1)
    return (jax.nn.silu(a) * b) @ w_out


def conv_module(u, w, bias, g, b):
    a, gt = jnp.split(u, 2, axis=-1)
    y = a * jax.nn.sigmoid(gt)
    pad = CONV_WIDTH // 2
    y = lax.conv_general_dilated(y, w[:, None, :].astype(y.dtype), window_strides=(1,),
                                 padding=[(pad, pad)], dimension_numbers=('NWC', 'WIO', 'NWC'),
                                 feature_group_count=C_CONV) + bias
    return jax.nn.silu(layer_norm(y, g, b))


def gla_features(z, w_a2, b_a):
    B, T, _ = z.shape
    q, k, v, gate, lr_f, lr_b = jnp.split(
        z, [W_GLA, 2 * W_GLA, 3 * W_GLA, 4 * W_GLA, 4 * W_GLA + GLA_RANK], axis=-1)
    heads = lambda t: t.reshape(B, T, H_GLA, -1).transpose(0, 2, 1, 3)
    logdec = lambda lr, d: heads(jax.nn.log_sigmoid((lr @ w_a2[d] + b_a[d]).astype(jnp.float32)) / GLA_TAU)
    return heads(q) * DK_GLA ** -0.5, heads(k), heads(v), gate, logdec(lr_f, 0), logdec(lr_b, 1)


def gla_chunked(q, k, v, g, s0):
    B, H, T, DK = q.shape
    DV = v.shape[-1]
    N = T // GLA_CHUNK
    f32 = jnp.float32
    qc = q.astype(f32).reshape(B, H, N, GLA_CHUNK, DK)
    kc = k.astype(f32).reshape(B, H, N, GLA_CHUNK, DK)
    vc = v.astype(f32).reshape(B, H, N, GLA_CHUNK, DV)
    G = jnp.cumsum(g.astype(f32).reshape(B, H, N, GLA_CHUNK, DK), axis=3)
    G_last = G[:, :, :, -1:, :]
    q_t = qc * jnp.exp(G)
    k_t = kc * jnp.exp(-G)
    k_hat = kc * jnp.exp(G_last - G)
    lower = jnp.tril(jnp.ones((GLA_CHUNK, GLA_CHUNK), dtype=bool))
    A = jnp.where(lower, jnp.einsum('bhncd,bhnsd->bhncs', q_t, k_t), 0.0)
    o_intra = jnp.einsum('bhncs,bhnsv->bhncv', A, vc)
    kv = jnp.einsum('bhnsd,bhnsv->bhndv', k_hat, vc)
    decay = jnp.exp(G_last[:, :, :, 0, :])

    def step(S, inp):
        d, u = inp
        return d[..., None] * S + u, S

    s_final, s_in = lax.scan(step, s0.astype(f32), (jnp.moveaxis(decay, 2, 0), jnp.moveaxis(kv, 2, 0)))
    s_in = jnp.moveaxis(s_in, 0, 2)
    o_inter = jnp.einsum('bhncd,bhndv->bhncv', q_t, s_in)
    return (o_intra + o_inter).reshape(B, H, T, DV), s_final


def axial_rope_tables(rows):
    row = jnp.repeat(jnp.arange(rows, dtype=jnp.float32), GRID_W)
    col = jnp.tile(jnp.arange(GRID_W, dtype=jnp.float32), rows)
    seg = DH_DIFF // 2
    inv = ROPE_BASE ** (-jnp.arange(0, seg, 2, dtype=jnp.float32) / seg)
    a_r = row[:, None] * inv
    a_c = col[:, None] * inv
    ang = jnp.concatenate([a_r, a_r, a_c, a_c], axis=-1)
    return jnp.cos(ang), jnp.sin(ang)


def apply_rope(x, cos, sin):
    xf = x.astype(jnp.float32)
    xr = xf.reshape(x.shape[:-1] + (2, 2, DH_DIFF // 4))
    rot = jnp.stack([-xr[..., 1, :], xr[..., 0, :]], axis=-2).reshape(x.shape)
    return (xf * cos[:, None, :] + rot * sin[:, None, :]).astype(x.dtype)


def diff_lambda(lam_p, layer_idx):
    lam_init = 0.8 - 0.6 * math.exp(-0.3 * layer_idx)
    p = lam_p.astype(jnp.float32)
    lam = jnp.exp(jnp.sum(p[0] * p[1])) - jnp.exp(jnp.sum(p[2] * p[3])) + lam_init
    return lam, lam_init


def diff_attend(q, k, v, lam):
    B, H, Tq = q.shape[:3]
    nb = Tq // Q_BLOCK
    qb = q.reshape(B, H, nb, Q_BLOCK, 2, DH_DIFF).transpose(2, 0, 1, 3, 4, 5)
    scale = DH_DIFF ** -0.5

    def block(qi):
        s = jnp.einsum('bhqmd,bhkmd->bhmqk', qi, k).astype(jnp.float32) * scale
        p = jax.nn.softmax(s, axis=-1)
        w = p[:, :, 0] - lam * p[:, :, 1]
        return jnp.einsum('bhqk,bhkv->bhqv', w.astype(v.dtype), v)

    o = lax.map(block, qb)
    return o.transpose(1, 2, 0, 3, 4).reshape(B, H, Tq, DV_DIFF)


def token_mixer(h, l, P, ctx):
    B, T, _ = h.shape
    z = h @ P['w_in'][l]
    z_conv, z_gla, z_diff = jnp.split(z, [IN_CONV, IN_CONV + IN_GLA], axis=-1)
    y_conv = conv_module(z_conv, P['conv_w'][l], P['conv_b'][l], P['conv_ln_g'][l], P['conv_ln_b'][l])
    q, k, v, gate, g_f, g_b = gla_features(z_gla, P['gla_w_a2'][l], P['gla_b_a'][l])
    if ctx is None:
        s_f0 = jnp.zeros((B, H_GLA, DK_GLA, DV_GLA), jnp.float32)
        s_b0 = s_f0
    else:
        s_f0 = ctx['state'][:, 0]
        s_b0 = ctx['state'][:, 1]
    flip = lambda t: jnp.flip(t, axis=2)
    o_f, s_f = gla_chunked(q, k, v, g_f, s_f0)
    o_b, s_b = gla_chunked(flip(q), flip(k), flip(v), flip(g_b), s_b0)
    o = (o_f + flip(o_b)).astype(h.dtype)
    y_gla = rms_norm(o, P['gla_norm_g'][l]).transpose(0, 2, 1, 3).reshape(B, T, W_GLA) * jax.nn.silu(gate)
    qd, kd, vd = jnp.split(z_diff, 3, axis=-1)
    qd = qd.reshape(B, T, H_DIFF, 2, DH_DIFF).transpose(0, 2, 1, 3, 4)
    kd = kd.reshape(B, T, H_DIFF, 2, DH_DIFF).transpose(0, 2, 1, 3, 4)
    vd = vd.reshape(B, T, H_DIFF, DV_DIFF).transpose(0, 2, 1, 3)
    if ctx is None:
        keys, vals = kd, vd
    else:
        qd = apply_rope(qd, ctx['cos'], ctx['sin'])
        ck = ctx['k'].reshape(B, H_DIFF, -1, 2, DH_DIFF)
        keys = jnp.concatenate([apply_rope(kd, ctx['cos'], ctx['sin']), ck], axis=2)
        vals = jnp.concatenate([vd, ctx['v']], axis=2)
    lam, lam_init = diff_lambda(P['diff_lam'][l], l)
    od = diff_attend(qd, keys, vals, lam)
    y_diff = (rms_norm(od, P['diff_norm_g'][l]) * (1.0 - lam_init)).transpose(0, 2, 1, 3).reshape(B, T, W_DIFF)
    y = jnp.concatenate([y_conv, y_gla, y_diff.astype(h.dtype)], axis=-1) @ P['w_out'][l]
    if ctx is None:
        new_ctx = (kd.reshape(B, H_DIFF, T, 2 * DH_DIFF), vd,
                   jnp.stack([s_f, s_b], axis=1).astype(h.dtype))
    else:
        new_ctx = None
    return y, new_ctx


def trunk_layer(x, mod, l, P, ctx):
    sh0, sc0, g0, sh1, sc1, g1, sh2, sc2, g2 = jnp.split(mod, N_MOD, axis=-1)
    h = x * (1.0 + sc0) + sh0
    x = layer_norm(ALPHA * x + 0.5 * g0 * swiglu_ffn(h, P['w_ffn1_in'][l], P['w_ffn1_out'][l]),
                   P['ln_g'][l, 0], P['ln_b'][l, 0])
    h = x * (1.0 + sc1) + sh1
    y, new_ctx = token_mixer(h, l, P, ctx)
    x = layer_norm(ALPHA * x + g1 * y, P['ln_g'][l, 1], P['ln_b'][l, 1])
    h = x * (1.0 + sc2) + sh2
    x = layer_norm(ALPHA * x + 0.5 * g2 * swiglu_ffn(h, P['w_ffn2_in'][l], P['w_ffn2_out'][l]),
                   P['ln_g'][l, 2], P['ln_b'][l, 2])
    return x, new_ctx


def setup_inputs(seed: int = 0) -> dict:
    key = jax.random.key(seed)
    ks = jax.random.split(key, 32)
    f32 = jnp.float32
    nrm = lambda k, shape, s: jax.random.normal(k, shape, f32) * s
    D = D_MODEL
    return {
        'x_prompt': nrm(ks[0], (BATCH, SEQ, D), 1.0),
        'x_sample': nrm(ks[1], (DEC_BATCH, DEC_SEQ, D), 1.0),
        'cache_diff_k': nrm(ks[2], (DEC_BATCH, DEPTH, H_DIFF, PAST_LEN, 2 * DH_DIFF), 1.0),
        'cache_diff_v': nrm(ks[3], (DEC_BATCH, DEPTH, H_DIFF, PAST_LEN, DV_DIFF), 1.0),
        'state_gla': nrm(ks[4], (DEC_BATCH, DEPTH, 2, H_GLA, DK_GLA, DV_GLA), 1.0),
        'c': nrm(ks[5], (DEC_BATCH, D), 1.0),
        'c_ctx': nrm(ks[6], (D,), 1.0),
        'w_ada': nrm(ks[7], (DEPTH, D, N_MOD * D), 0.5 * D ** -0.5),
        'b_ada': nrm(ks[8], (DEPTH, N_MOD * D), 0.01),
        'w_ffn1_in': nrm(ks[9], (DEPTH, D, 2 * D_FF), D ** -0.5),
        'w_ffn1_out': nrm(ks[10], (DEPTH, D_FF, D), BETA * D_FF ** -0.5),
        'w_ffn2_in': nrm(ks[11], (DEPTH, D, 2 * D_FF), D ** -0.5),
        'w_ffn2_out': nrm(ks[12], (DEPTH, D_FF, D), BETA * D_FF ** -0.5),
        'w_in': nrm(ks[13], (DEPTH, D, IN_COLS), D ** -0.5),
        'conv_w': nrm(ks[14], (DEPTH, CONV_WIDTH, C_CONV), CONV_WIDTH ** -0.5),
        'conv_b': nrm(ks[15], (DEPTH, C_CONV), 0.01),
        'conv_ln_g': 1.0 + nrm(ks[16], (DEPTH, C_CONV), 0.01),
        'conv_ln_b': nrm(ks[17], (DEPTH, C_CONV), 0.01),
        'gla_w_a2': nrm(ks[18], (DEPTH, 2, GLA_RANK, W_GLA), GLA_RANK ** -0.5),
        'gla_b_a': nrm(ks[19], (DEPTH, 2, W_GLA), 0.01),
        'gla_norm_g': 1.0 + nrm(ks[20], (DEPTH, DV_GLA), 0.01),
        'diff_lam': nrm(ks[21], (DEPTH, 4, DH_DIFF), 0.1),
        'diff_norm_g': 1.0 + nrm(ks[22], (DEPTH, DV_DIFF), 0.01),
        'w_out': nrm(ks[23], (DEPTH, D_MIX, D), BETA * D_MIX ** -0.5),
        'ln_g': 1.0 + nrm(ks[24], (DEPTH, 3, D), 0.01),
        'ln_b': nrm(ks[25], (DEPTH, 3, D), 0.01),
    }


def reference(x_prompt, x_sample, cache_diff_k, cache_diff_v, state_gla, c, c_ctx,
              w_ada, b_ada, w_ffn1_in, w_ffn1_out, w_ffn2_in, w_ffn2_out, w_in,
              conv_w, conv_b, conv_ln_g, conv_ln_b, gla_w_a2, gla_b_a, gla_norm_g,
              diff_lam, diff_norm_g, w_out, ln_g, ln_b):
    P = dict(w_ffn1_in=w_ffn1_in, w_ffn1_out=w_ffn1_out, w_ffn2_in=w_ffn2_in, w_ffn2_out=w_ffn2_out,
             w_in=w_in, conv_w=conv_w, conv_b=conv_b, conv_ln_g=conv_ln_g, conv_ln_b=conv_ln_b,
             gla_w_a2=gla_w_a2, gla_b_a=gla_b_a, gla_norm_g=gla_norm_g, diff_lam=diff_lam,
             diff_norm_g=diff_norm_g, w_out=w_out, ln_g=ln_g, ln_b=ln_b)
    xp = x_prompt
    new_k, new_v, new_s = [], [], []
    for l in range(DEPTH):
        mod = (jax.nn.silu(c_ctx[None, :]) @ w_ada[l] + b_ada[l])[:, None, :]
        xp, (k_l, v_l, s_l) = trunk_layer(xp, mod, l, P, None)
        new_k.append(k_l)
        new_v.append(v_l)
        new_s.append(s_l)
    rows = x_sample.shape[1] // GRID_W
    cos, sin = axial_rope_tables(rows)
    xs = x_sample
    for l in range(DEPTH):
        mod = (jax.nn.silu(c) @ w_ada[l] + b_ada[l])[:, None, :]
        ctx = dict(k=cache_diff_k[:, l], v=cache_diff_v[:, l], state=state_gla[:, l], cos=cos, sin=sin)
        xs, _ = trunk_layer(xs, mod, l, P, ctx)
    new_diff_k = jnp.stack(new_k, axis=1)
    new_diff_v = jnp.stack(new_v, axis=1)
    new_gla = jnp.stack(new_s, axis=1)
    return (xp, xs, new_diff_k, new_diff_v, new_gla)
```

```cpp
#include <hip/hip_runtime.h>
#include <hip/hip_cooperative_groups.h>
#include <cstdio>
#include <cstdint>
namespace cg = cooperative_groups;
#ifndef MK_PER_PHASE
#define MK_PER_PHASE 0
#endif
#ifndef PHM
#define PHM 0xFFFF
#endif
#ifndef PROBE
#define PROBE 0
#endif
#ifndef GLA_MFMA
#define GLA_MFMA 1
#endif
#ifndef FAST_BAR
#define FAST_BAR 1
#endif
#ifndef KSPLIT
#define KSPLIT 2
#endif
namespace pg8 {
#define PG8_LAS __attribute__((address_space(3)))
typedef unsigned short bf16_t;
typedef short bf16x8 __attribute__((ext_vector_type(8)));
typedef float f32x4 __attribute__((ext_vector_type(4)));
typedef unsigned u32x4 __attribute__((ext_vector_type(4)));
constexpr int BM = 256, BK = 64, HALF = 128, HTB = HALF * BK * 2  , STAGE_BYTES = 8 * HTB, NXCD = 8, WGM = 4;

__host__ __device__ __forceinline__ int lds_byte(int r, int c) { const int st = (r >> 4) * 2 + (c >> 5), rr = r & 15, cc = c & 31, ob = rr * 64 + cc * 2; return st * 1024 + (ob ^ (((ob >> 9) & 1) << 5)); }
__host__ __device__ __forceinline__ void stage_rc(int b, int& R, int& C) { const int st = b / 1024, sb = b % 1024, swz = sb ^ (((sb >> 9) & 1) << 5); R = (st >> 1) * 16 + swz / 64; C = (st & 1) * 32 + (swz % 64) / 2; }
__host__ __device__ __forceinline__ int perm32(int rho) { const int n = rho >> 4, i = rho & 15; return 8 * (i >> 2) + 4 * n + (i & 3); }

struct Unit { int pm, pn, kt0, nkt, split; };
struct Gemm { const bf16_t* A; const bf16_t* Bt; int M, N, K; };

struct StaticOrder {
    int nM, nN, nwg, G, c, ntk, nsplit, rev;
    __host__ __device__ void init(int M, int N, int K, int G_, int c_) { nM = M / BM; nN = N / BM; nwg = nM * nN; G = G_; c = c_; ntk = K / BK; nsplit = 0; rev = 0; }
    __host__ __device__ void map(int wgid, int nwgv, int nMv, Unit& u) const {
        { const int q = nwgv / NXCD, r = nwgv % NXCD, xcd = wgid % NXCD, off = wgid / NXCD; wgid = (xcd < r ? xcd * (q + 1) : r * (q + 1) + (xcd - r) * q) + off; }
        const int nig = WGM * nN, gid = wgid / nig, fm = gid * WGM, gsz = (nMv - fm) < WGM ? (nMv - fm) : WGM;
        u.pm = fm + ((wgid % nig) % gsz); u.pn = (wgid % nig) / gsz;
    }
    __host__ __device__ bool next(int i, Unit& u) const {
        u.kt0 = 0; u.nkt = ntk; u.split = -1;
        if (nsplit > 0) {
            const int nS = (nM - 16) * nN, fullr = nS / G;
            if (i < fullr) { map(i * G + c, nS, nM - 16, u); u.pm = 16 + (rev ? (nM - 17 - u.pm) : u.pm); return true; }
            if (i > fullr || c >= 16 * nN * nsplit) return false;
            const int un = c / nsplit; u.split = c % nsplit; u.pm = un / nN; u.pn = un % nN; u.nkt = ntk / nsplit; u.kt0 = u.split * u.nkt; return true;
        }
        const long L = (long)i * G + c; if (L >= nwg) return false;
        map((int)L, nwg, nM, u); return true;
    }
    __device__ __forceinline__ void a_ready(const Unit&) const {}
    __device__ __forceinline__ void done(const Unit&) const {}
};

__device__ __forceinline__ unsigned cvt_pk_bf16(float lo, float hi) { unsigned r; asm volatile("v_cvt_pk_bf16_f32 %0, %1, %2" : "=v"(r) : "v"(lo), "v"(hi)); return r; }
typedef float f32x2 __attribute__((ext_vector_type(2)));
typedef unsigned u32x2v __attribute__((ext_vector_type(2)));
template <class Epi, class Sched, bool ALIGN_EPI = false, bool SP2 = false>
__device__ __forceinline__ void gemm_phase(PG8_LAS unsigned char* lds, const Gemm g, const Sched& S, const Epi& E) {
    int tid_ = threadIdx.x; asm volatile("" : "+v"(tid_)); const int tid = tid_, wid = __builtin_amdgcn_readfirstlane(tid >> 6), lane = tid & 63, wr = wid >> 2, wc = wid & 3, fr = lane & 15, fq = lane >> 4;
    const int K = g.K, nt = K / BK;
    unsigned voffA[2], voffB[2];
#pragma unroll
    for (int i = 0; i < 2; ++i) { int R, C; stage_rc(tid * 16 + i * 8192, R, C); const int Rb = E.perm() ? ((R & ~31) + perm32(R & 31)) : R;
        voffA[i] = (unsigned)(R * K + C) * 2u; voffB[i] = (unsigned)(Rb * K + C) * 2u; }
    const size_t kstep = (size_t)(BK * 2);
    const size_t hstep = (size_t)HALF * K * 2;
    const size_t tstep = 2 * hstep;
    const unsigned ldsw = (unsigned)wid * 1024u;
    const int aoff = lds_byte(wr * 64 + fr, fq * 8), boff = lds_byte(wc * 32 + fr, fq * 8);
#define PG8_SA(b, h) (((b) * 2 + (h)) * HTB)
#define PG8_SB(b, h) ((4 + (b) * 2 + (h)) * HTB)
#define PG8_STAGE(bufoff, gbase, voff) do { _Pragma("unroll") for (int _i = 0; _i < 2; ++_i) \
        __builtin_amdgcn_global_load_lds((const unsigned*)((const char*)(gbase) + (voff)[_i]), (PG8_LAS unsigned*)(lds + (bufoff) + ldsw + _i * 8192), 16, 0, 0); } while (0)
#define PG8_LDA(dst, b, h) do { _Pragma("unroll") for (int m = 0; m < 4; ++m) _Pragma("unroll") for (int k = 0; k < 2; ++k) dst[m][k] = *(const PG8_LAS bf16x8*)(lds + PG8_SA(b, h) + aoff + m * 2048 + k * 1024); } while (0)
#define PG8_LDB(dst, b, h) do { _Pragma("unroll") for (int n = 0; n < 2; ++n) _Pragma("unroll") for (int k = 0; k < 2; ++k) dst[n][k] = *(const PG8_LAS bf16x8*)(lds + PG8_SB(b, h) + boff + n * 2048 + k * 1024); } while (0)
#define PG8_MMA(ai, bj, At, Bt) do { __builtin_amdgcn_s_setprio(1); _Pragma("unroll") for (int m = 0; m < 4; ++m) _Pragma("unroll") for (int n = 0; n < 2; ++n) _Pragma("unroll") for (int k = 0; k < 2; ++k) \
        acc[ai][bj][m][n] = __builtin_amdgcn_mfma_f32_16x16x32_bf16(Bt[n][k], At[m][k], acc[ai][bj][m][n], 0, 0, 0); __builtin_amdgcn_s_setprio(0); } while (0)
#define PG8_WAIT_V(n) asm volatile("s_waitcnt vmcnt(" #n ")" ::: "memory")
#define PG8_WAIT_L(n) asm volatile("s_waitcnt lgkmcnt(" #n ")" ::: "memory")
#define PG8_BAR __builtin_amdgcn_s_barrier()
#define PG8_SCHED __builtin_amdgcn_sched_barrier(0)
    Unit cur, nxt; int ui = 0;
    if (!S.next(0, cur)) return;
    f32x4 acc[2][2][4][2];
#pragma unroll
    for (int a = 0; a < 2; ++a)
#pragma unroll
        for (int b = 0; b < 2; ++b)
#pragma unroll
            for (int m = 0; m < 4; ++m)
#pragma unroll
                for (int n = 0; n < 2; ++n) acc[a][b][m][n] = (f32x4){0.f, 0.f, 0.f, 0.f};
    bf16x8 At[4][2], B0[2][2], B1[2][2];
    const char* cA = (const char*)g.A + (size_t)cur.pm * tstep + (size_t)cur.kt0 * kstep; const char* cB = (const char*)g.Bt + (size_t)cur.pn * tstep + (size_t)cur.kt0 * kstep;
    S.a_ready(cur);
    if constexpr (SP2) {
        PG8_STAGE(PG8_SB(0, 0), cB, voffB); PG8_STAGE(PG8_SB(0, 1), cB + hstep, voffB); PG8_STAGE(PG8_SA(0, 0), cA, voffA); PG8_STAGE(PG8_SA(0, 1), cA + hstep, voffA);
        if (wr == 1) PG8_BAR;
        PG8_WAIT_V(2); PG8_BAR;
        PG8_STAGE(PG8_SB(1, 0), cB + kstep, voffB); PG8_STAGE(PG8_SA(1, 0), cA + kstep, voffA); PG8_STAGE(PG8_SB(1, 1), cB + hstep + kstep, voffB);
        PG8_WAIT_V(6); PG8_BAR;
    } else {
        PG8_STAGE(PG8_SB(0, 0), cB, voffB); PG8_STAGE(PG8_SA(0, 0), cA, voffA); PG8_STAGE(PG8_SB(0, 1), cB + hstep, voffB); PG8_STAGE(PG8_SA(0, 1), cA + hstep, voffA);
        if (wr == 1) PG8_BAR;
        PG8_WAIT_V(4); PG8_BAR;
        PG8_STAGE(PG8_SB(1, 0), cB + kstep, voffB); PG8_STAGE(PG8_SA(1, 0), cA + kstep, voffA); PG8_STAGE(PG8_SB(1, 1), cB + hstep + kstep, voffB);
        PG8_WAIT_V(6); PG8_BAR;
    }
    for (;;) {
        const bool has_next = S.next(ui + 1, nxt);
        const char* nA = has_next ? (const char*)g.A + (size_t)nxt.pm * tstep + (size_t)nxt.kt0 * kstep : cA; const char* nB = has_next ? (const char*)g.Bt + (size_t)nxt.pn * tstep + (size_t)nxt.kt0 * kstep : cB;
        const int ntu = cur.nkt;
        for (int t = 0; t < ntu; t += 2) {
            const bool last = (t == ntu - 2);
            const char* a1 = cA + (size_t)(t + 1) * kstep;
            const char* a2 = last ? nA : cA + (size_t)(t + 2) * kstep; const char* b2 = last ? nB : cB + (size_t)(t + 2) * kstep;
            const char* a3 = a2 + kstep; const char* b3 = b2 + kstep;
            if (last && has_next) S.a_ready(nxt);
            if constexpr (SP2) {
            PG8_LDB(B0, 0, 0); PG8_LDB(B1, 0, 1); PG8_SCHED; PG8_LDA(At, 0, 0); PG8_STAGE(PG8_SA(1, 1), a1 + hstep, voffA);
            PG8_WAIT_V(8); PG8_WAIT_L(0); PG8_BAR; PG8_MMA(0, 0, At, B0); PG8_MMA(0, 1, At, B1); PG8_BAR; PG8_SCHED;
            PG8_LDA(At, 0, 1); PG8_STAGE(PG8_SB(0, 0), b2, voffB); PG8_STAGE(PG8_SB(0, 1), b2 + hstep, voffB); PG8_STAGE(PG8_SA(0, 0), a2, voffA);
            PG8_WAIT_V(8); PG8_WAIT_L(0); PG8_BAR; PG8_MMA(1, 0, At, B0); PG8_MMA(1, 1, At, B1); PG8_BAR; PG8_SCHED;
            PG8_LDB(B0, 1, 0); PG8_LDB(B1, 1, 1); PG8_SCHED; PG8_LDA(At, 1, 0); PG8_STAGE(PG8_SA(0, 1), a2 + hstep, voffA);
            PG8_WAIT_V(8); PG8_WAIT_L(0); PG8_BAR; PG8_MMA(0, 0, At, B0); PG8_MMA(0, 1, At, B1); PG8_BAR; PG8_SCHED;
            PG8_LDA(At, 1, 1); PG8_STAGE(PG8_SB(1, 0), b3, voffB); PG8_STAGE(PG8_SB(1, 1), b3 + hstep, voffB); PG8_STAGE(PG8_SA(1, 0), a3, voffA);
            PG8_WAIT_V(8); PG8_WAIT_L(0); PG8_BAR; PG8_MMA(1, 0, At, B0); PG8_MMA(1, 1, At, B1); PG8_BAR; PG8_SCHED;
            } else {
            PG8_LDB(B0, 0, 0); PG8_SCHED; PG8_LDA(At, 0, 0); PG8_STAGE(PG8_SA(1, 1), a1 + hstep, voffA);
            PG8_WAIT_L(8); PG8_BAR; PG8_WAIT_L(0); PG8_MMA(0, 0, At, B0); PG8_BAR; PG8_SCHED;
            PG8_LDB(B1, 0, 1); PG8_STAGE(PG8_SB(0, 0), b2, voffB);
            PG8_BAR; PG8_WAIT_L(0); PG8_MMA(0, 1, At, B1); PG8_BAR;
            PG8_LDA(At, 0, 1); PG8_STAGE(PG8_SA(0, 0), a2, voffA);
            PG8_BAR; PG8_WAIT_L(0); PG8_MMA(1, 0, At, B0); PG8_BAR; PG8_SCHED;
            PG8_STAGE(PG8_SB(0, 1), b2 + hstep, voffB);
            PG8_WAIT_V(6); PG8_BAR; PG8_MMA(1, 1, At, B1); PG8_BAR;
            PG8_LDB(B0, 1, 0); PG8_SCHED; PG8_LDA(At, 1, 0); PG8_STAGE(PG8_SA(0, 1), a2 + hstep, voffA);
            PG8_WAIT_L(8); PG8_BAR; PG8_WAIT_L(0); PG8_MMA(0, 0, At, B0); PG8_BAR; PG8_SCHED;
            PG8_LDB(B1, 1, 1); PG8_STAGE(PG8_SB(1, 0), b3, voffB);
            PG8_BAR; PG8_WAIT_L(0); PG8_MMA(0, 1, At, B1); PG8_BAR;
            PG8_LDA(At, 1, 1); PG8_STAGE(PG8_SA(1, 0), a3, voffA);
            PG8_BAR; PG8_WAIT_L(0); PG8_MMA(1, 0, At, B0); PG8_BAR; PG8_SCHED;
            PG8_STAGE(PG8_SB(1, 1), b3 + hstep, voffB);
            PG8_WAIT_V(6); PG8_BAR; PG8_MMA(1, 1, At, B1); PG8_BAR;
            }
        }
        if constexpr (ALIGN_EPI) { if (wr == 0) PG8_BAR; }
        if constexpr (!Epi::AFTER_DRAIN) { E(acc, cur, wr, wc, fr, fq); S.done(cur); }
        if (!has_next) break;
#pragma unroll
        for (int a = 0; a < 2; ++a)
#pragma unroll
            for (int b = 0; b < 2; ++b)
#pragma unroll
                for (int m = 0; m < 4; ++m)
#pragma unroll
                    for (int n = 0; n < 2; ++n) acc[a][b][m][n] = (f32x4){0.f, 0.f, 0.f, 0.f};
        cur = nxt; cA = nA; cB = nB; ++ui;
        if constexpr (ALIGN_EPI) { if (wr == 1) PG8_BAR; }
    }
    PG8_WAIT_V(0);
    if constexpr (!ALIGN_EPI) { if (wr == 0) PG8_BAR; }
    PG8_BAR;
    if constexpr (Epi::AFTER_DRAIN) { E.fused(acc, cur, wr, wc, fr, fq, lds, wid, lane); S.done(cur); }
#undef PG8_SA
#undef PG8_SB
#undef PG8_STAGE
#undef PG8_LDA
#undef PG8_LDB
#undef PG8_MMA
#undef PG8_WAIT_V
#undef PG8_WAIT_L
#undef PG8_BAR
#undef PG8_SCHED
}
}

#define LAS __attribute__((address_space(3)))
typedef unsigned short bf16;
typedef unsigned v4u __attribute__((ext_vector_type(4)));
typedef unsigned v2u __attribute__((ext_vector_type(2)));
typedef float f32x4 __attribute__((ext_vector_type(4)));
typedef float f32x16 __attribute__((ext_vector_type(16)));
typedef short bf16x8 __attribute__((ext_vector_type(8)));
typedef short s16x4 __attribute__((ext_vector_type(4)));

constexpr int D = 1024, MPR = 4096, M = 36864, DFF = 2816, NZ = 3328, NTC = 576;
constexpr int ZC_GQ = 512, ZC_GK = 768, ZC_GV = 1024, ZC_GG = 1280, ZC_DQ = 1536, ZC_DK = 2048, ZC_DV = 2560;
constexpr float ALPHA = 1.41421356237309505f, LN_EPS = 1e-5f;
constexpr size_t MiB = 1u << 20;
constexpr size_t WS_MOD = 1 * MiB, WS_DEC = 2 * MiB, WS_LR = 4 * MiB, WS_CK = 9 * MiB, WS_CV = 17 * MiB, WS_W = 25 * MiB;
constexpr size_t W1I = 0, W1O = 5767168, W2I = 8650752, W2O = 14417920, WIN = 17301504, WOUT = 20709376, WL_ELEMS = 21757952;
constexpr size_t WS_H = 108 * MiB, WS_UZ = 180 * MiB, WS_V = 414 * MiB, WS_END = 486 * MiB, WS_PART = WS_UZ + 198 * MiB, PART_SLICE = (size_t)MPR * D, WS_STATS = 512 * 1024, WS_ONES = 896 * 1024;
constexpr size_t OUT_K = 37748736, OUT_V = 41943040, OUT_G = 46137344;
constexpr int LDS_BYTES = 147456;


#define OPQ_IDS() int BID = blockIdx.x, NB = gridDim.x; asm volatile("" : "+s"(BID), "+s"(NB))
struct Args { const float* in[26]; float* out; unsigned char* ws; int ph_lo, ph_hi, coop, pad; };

__device__ __forceinline__ float bf2f(unsigned short b) { return __uint_as_float((unsigned)b << 16); }
__device__ __forceinline__ float bflo(unsigned w) { return __uint_as_float(w << 16); }
__device__ __forceinline__ float bfhi(unsigned w) { return __uint_as_float(w & 0xffff0000u); }
__device__ __forceinline__ unsigned pk2(float lo, float hi) { return pg8::cvt_pk_bf16(lo, hi); }
__device__ __forceinline__ float shx(float v, int o, int lane) { return __int_as_float(__builtin_amdgcn_ds_bpermute((lane ^ o) << 2, __float_as_int(v))); }
__device__ __forceinline__ float wave_sum(float v, int lane) {
#pragma unroll
    for (int o = 1; o < 64; o <<= 1) v += shx(v, o, lane);
    return v;
}
__device__ __forceinline__ float sigmoidf_(float x) { return __builtin_amdgcn_rcpf(1.f + __expf(-x)); }
__device__ __forceinline__ float siluf_(float x) { return x * sigmoidf_(x); }
__device__ __forceinline__ float logsig(float x) { return fminf(x, 0.f) - __logf(1.f + __expf(-fabsf(x))); }
__device__ __forceinline__ void tc_decode(int tc, int& m0, int& ms0, int& T) {
    if (tc < 64) { ms0 = (tc >> 2) * 256; T = 256; m0 = ms0 + (tc & 3) * 64; }
    else { const int s = tc - 64; ms0 = MPR + (s >> 6) * 4096; T = 4096; m0 = ms0 + (s & 63) * 64; }
}

namespace pg8 {
struct EpiSwiglu {
    static constexpr bool PERM = true, AFTER_DRAIN = false;
    bf16_t* U;
    __device__ __forceinline__ void operator()(const f32x4 (&acc)[2][2][4][2], const Unit& u, int wr, int wc, int fr, int fq) const {
        const int row0 = u.pm * BM + wr * 64 + fr, col0 = u.pn * 128 + wc * 32 + 8 * fq;
#pragma unroll
        for (int ai = 0; ai < 2; ++ai)
#pragma unroll
            for (int m = 0; m < 4; ++m) {
                bf16_t* p = U + (size_t)(row0 + ai * HALF + m * 16) * DFF + col0;
                const f32x4 a0 = acc[ai][0][m][0], a1 = acc[ai][0][m][1], b0 = acc[ai][1][m][0], b1 = acc[ai][1][m][1];
                float r[8];
#pragma unroll
                for (int e = 0; e < 4; ++e) { r[e] = siluf_(a0[e]) * b0[e]; r[4 + e] = siluf_(a1[e]) * b1[e]; }
                u32x4 w; w.x = cvt_pk_bf16(r[0], r[1]); w.y = cvt_pk_bf16(r[2], r[3]); w.z = cvt_pk_bf16(r[4], r[5]); w.w = cvt_pk_bf16(r[6], r[7]);
                *(u32x4*)p = w;
            }
    }
};
struct EpiResid {
    static constexpr bool PERM = true, AFTER_DRAIN = false;
    bf16_t* V; const float* stats; const float* lg; const float* lb; const float* mod; float gs; float* part;
    __device__ __forceinline__ void operator()(const f32x4 (&acc)[2][2][4][2], const Unit& u, int wr, int wc, int fr, int fq) const {
        const int mrow = (u.pm < 16) ? 0 : 1 + ((u.pm - 16) >> 4);
        const float* g = mod + (size_t)mrow * 9216;
        const int col0 = u.pn * BM + wc * 32 + 8 * fq, row0 = u.pm * BM + wr * 64 + fr;
        if (u.split >= 0) {
            float* ps = part + (size_t)u.split * PART_SLICE;
#pragma unroll
            for (int bj = 0; bj < 2; ++bj)
#pragma unroll
                for (int ai = 0; ai < 2; ++ai)
#pragma unroll
                    for (int m = 0; m < 4; ++m) { float* p = ps + (size_t)(row0 + ai * HALF + m * 16) * D + col0 + bj * HALF; *(f32x4*)p = acc[ai][bj][m][0]; *(f32x4*)(p + 4) = acc[ai][bj][m][1]; }
            return;
        }
#pragma unroll
        for (int bj = 0; bj < 2; ++bj) {
            const int col = col0 + bj * HALF;
            const f32x4 gv0 = *(const f32x4*)(g + col) * gs, gv1 = *(const f32x4*)(g + col + 4) * gs;
            const f32x4 lg0 = *(const f32x4*)(lg + col), lg1 = *(const f32x4*)(lg + col + 4), lb0 = *(const f32x4*)(lb + col), lb1 = *(const f32x4*)(lb + col + 4);
#pragma unroll
            for (int ai = 0; ai < 2; ++ai)
#pragma unroll
                for (int m = 0; m < 4; ++m) {
                    const int row = row0 + ai * HALF + m * 16;
                    bf16_t* p = V + (size_t)row * D + col;
                    const u32x4 w = *(const u32x4*)p; const f32x2 st = *(const f32x2*)(stats + 2 * row);
                    f32x4 x0 = (f32x4){bflo(w.x), bfhi(w.x), bflo(w.y), bfhi(w.y)}, x1 = (f32x4){bflo(w.z), bfhi(w.z), bflo(w.w), bfhi(w.w)};
                    x0 = (x0 - st.x) * st.y * lg0 + lb0; x1 = (x1 - st.x) * st.y * lg1 + lb1;
                    const f32x4 n0 = x0 * ALPHA + gv0 * acc[ai][bj][m][0], n1 = x1 * ALPHA + gv1 * acc[ai][bj][m][1];
                    u32x4 o; o.x = cvt_pk_bf16(n0[0], n0[1]); o.y = cvt_pk_bf16(n0[2], n0[3]); o.z = cvt_pk_bf16(n1[0], n1[1]); o.w = cvt_pk_bf16(n1[2], n1[3]);
                    *(u32x4*)p = o;
                }
        }
    }
};
struct EpiWin {
    static constexpr bool PERM = true, AFTER_DRAIN = false;
    bf16_t* Z; float* LR; float* outk; float* outv;
    __device__ __forceinline__ void operator()(const f32x4 (&acc)[2][2][4][2], const Unit& u, int wr, int wc, int fr, int fq) const {
        const int pn = u.pn, row0 = u.pm * BM + wr * 64 + fr, lane = fq * 16 + fr;
        const bool sample = u.pm >= 16;
        if (pn == 12) {
            if (wc == 0) {
#pragma unroll
                for (int ai = 0; ai < 2; ++ai)
#pragma unroll
                    for (int m = 0; m < 4; ++m)
#pragma unroll
                        for (int n = 0; n < 2; ++n) *(f32x4*)(LR + (size_t)(row0 + ai * HALF + m * 16) * 32 + 8 * fq + 4 * n) = acc[ai][0][m][n];
            }
            return;
        }
        const float scale = (pn == 2) ? 0.125f : ((pn == 6 || pn == 7) ? 0.125f * 1.4426950408889634f : 1.f);
        const bool rope = sample && pn >= 6 && pn <= 9;
        const bool ctxout = (!sample) && pn >= 8;
        float invf[2][4];
#pragma unroll
        for (int n = 0; n < 2; ++n)
#pragma unroll
            for (int e = 0; e < 4; ++e) invf[n][e] = __builtin_amdgcn_exp2f(-(float)(8 * (fq & 1) + 4 * n + e) * 0.83048202372184059f);
        const float sgn = (fq & 2) ? 1.f : -1.f;
#pragma unroll
        for (int ai = 0; ai < 2; ++ai)
#pragma unroll
            for (int m = 0; m < 4; ++m) {
                const int row = row0 + ai * HALF + m * 16;
                f32x4 v[2][2];
#pragma unroll
                for (int bj = 0; bj < 2; ++bj)
#pragma unroll
                    for (int n = 0; n < 2; ++n) v[bj][n] = acc[ai][bj][m][n];
                if (ctxout) {
                    float* ob = (pn < 10) ? outk : outv;
                    const int b = row >> 8, t = row & 255;
#pragma unroll
                    for (int bj = 0; bj < 2; ++bj) {
                        const int kcol = (pn & 1) * 256 + 128 * bj + 32 * wc + 8 * fq, hh = kcol >> 7, j = kcol & 127;
                        float* op = ob + ((size_t)((b * 8 + hh) * 256 + t)) * 128 + j;
                        *(f32x4*)op = v[bj][0]; *(f32x4*)(op + 4) = v[bj][1];
                    }
                }
                if (rope) {
                    const int t = (row - MPR) & 4095;
                    const float pos = (float)((wc & 1) ? (t & 63) : (t >> 6));
#pragma unroll
                    for (int n = 0; n < 2; ++n)
#pragma unroll
                        for (int e = 0; e < 4; ++e) {
                            const float ang = pos * invf[n][e], cs = __cosf(ang), sn = __sinf(ang) * sgn;
#pragma unroll
                            for (int bj = 0; bj < 2; ++bj) { const float x = v[bj][n][e], xp = shx(x, 32, lane); v[bj][n][e] = x * cs + xp * sn; }
                        }
                }
#pragma unroll
                for (int bj = 0; bj < 2; ++bj) {
                    bf16_t* p = Z + (size_t)row * NZ + pn * 256 + 128 * bj + 32 * wc + 8 * fq;
                    const f32x4 x0 = v[bj][0] * scale, x1 = v[bj][1] * scale;
                    u32x4 w; w.x = cvt_pk_bf16(x0[0], x0[1]); w.y = cvt_pk_bf16(x0[2], x0[3]); w.z = cvt_pk_bf16(x1[0], x1[1]); w.w = cvt_pk_bf16(x1[2], x1[3]);
                    *(u32x4*)p = w;
                }
            }
    }
};
struct EpiAny {
    static constexpr bool AFTER_DRAIN = false;
    const Args& a; int kind, l, gi; float gs; int lnidx;
    __device__ __forceinline__ bool perm() const { return true; }
    __device__ __forceinline__ void operator()(const f32x4 (&acc)[2][2][4][2], const Unit& u, int wr, int wc, int fr, int fq) const {
        if (kind == 3) {
#pragma unroll
            for (int ai = 0; ai < 2; ++ai)
#pragma unroll
                for (int bj = 0; bj < 2; ++bj)
#pragma unroll
                    for (int m = 0; m < 4; ++m)
#pragma unroll
                        for (int n = 0; n < 2; ++n) asm volatile("" :: "v"(acc[ai][bj][m][n]));
            return;
        }
        if (kind == 0) { EpiSwiglu e{(bf16_t*)(a.ws + WS_UZ)}; e(acc, u, wr, wc, fr, fq); }
        else if (kind == 1) { const float* ones = (const float*)(a.ws + WS_ONES); EpiResid e{(bf16_t*)(a.ws + WS_V), (const float*)(a.ws + WS_STATS), lnidx < 0 ? ones : a.in[24] + lnidx * D, lnidx < 0 ? ones + D : a.in[25] + lnidx * D, (const float*)(a.ws + WS_MOD) + (size_t)l * 9 * 9216 + gi * 1024, gs, (float*)(a.ws + WS_PART)}; e(acc, u, wr, wc, fr, fq); }
        else { EpiWin e{(bf16_t*)(a.ws + WS_UZ), (float*)(a.ws + WS_LR), a.out + OUT_K + (size_t)l * 4 * 256 * 128, a.out + OUT_V + (size_t)l * 4 * 256 * 128}; e(acc, u, wr, wc, fr, fq); }
    }
};
}

__device__ __forceinline__ void transpose_item(const float* W, int K, int N, bf16* WT, int k0, int n0, int drow0, float* scr, int lane) {
#pragma unroll 8
    for (int i = 0; i < 32; ++i) { const int kk = 2 * i + (lane >> 5); scr[kk * 33 + (lane & 31)] = W[(size_t)(k0 + kk) * N + n0 + (lane & 31)]; }
    asm volatile("s_waitcnt lgkmcnt(0)" ::: "memory");
    const int c = lane & 7;
#pragma unroll
    for (int j = 0; j < 4; ++j) {
        const int n = (lane >> 3) + 8 * j; const float* s = scr + (8 * c) * 33 + n;
        v4u o; o.x = pk2(s[0 * 33], s[1 * 33]); o.y = pk2(s[2 * 33], s[3 * 33]); o.z = pk2(s[4 * 33], s[5 * 33]); o.w = pk2(s[6 * 33], s[7 * 33]);
        *(v4u*)(WT + (size_t)(drow0 + n) * K + k0 + 8 * c) = o;
    }
    asm volatile("s_waitcnt lgkmcnt(0)" ::: "memory");
}

__device__ __forceinline__ void phase_prologue(const Args& a, unsigned char* lds, int tid, int lane, int wave) {
    OPQ_IDS();
    float* scr = (float*)lds + wave * 4096;
    const int gw = BID * 8 + wave, NGW = NB * 8;
    const int gt = BID * 512 + tid, NGT = NB * 512;
    constexpr int PER_L = 10512;
    for (int it = gw; it < 2 * PER_L; it += NGW) {
        const int l = it / PER_L; int r = it % PER_L;
        bf16* wl = (bf16*)(a.ws + WS_W) + (size_t)l * WL_ELEMS;
        if (r < 2816) { const int kb = r / 176, n0 = (r % 176) * 32, j = n0 < DFF ? n0 : n0 - DFF, dr = 256 * (j / 128) + (j % 128) + (n0 < DFF ? 0 : 128);
            transpose_item(a.in[9] + (size_t)l * 1024 * 5632, 1024, 5632, wl + W1I, kb * 64, n0, dr, scr, lane); continue; } r -= 2816;
        if (r < 1408) { const int kb = r / 32, n0 = (r % 32) * 32; transpose_item(a.in[10] + (size_t)l * DFF * 1024, DFF, 1024, wl + W1O, kb * 64, n0, n0, scr, lane); continue; } r -= 1408;
        if (r < 2816) { const int kb = r / 176, n0 = (r % 176) * 32, j = n0 < DFF ? n0 : n0 - DFF, dr = 256 * (j / 128) + (j % 128) + (n0 < DFF ? 0 : 128);
            transpose_item(a.in[11] + (size_t)l * 1024 * 5632, 1024, 5632, wl + W2I, kb * 64, n0, dr, scr, lane); continue; } r -= 2816;
        if (r < 1408) { const int kb = r / 32, n0 = (r % 32) * 32; transpose_item(a.in[12] + (size_t)l * DFF * 1024, DFF, 1024, wl + W2O, kb * 64, n0, n0, scr, lane); continue; } r -= 1408;
        if (r < 1552) { const int kb = r / 97, n0 = (r % 97) * 32, dr = n0 < 1536 ? n0 : (n0 < 1568 ? 3072 : n0 - 32);
            transpose_item(a.in[13] + (size_t)l * 1024 * 3104, 1024, 3104, wl + WIN, kb * 64, n0, dr, scr, lane); continue; } r -= 1552;
        { const int kb = r / 32, n0 = (r % 32) * 32; transpose_item(a.in[23] + (size_t)l * 1024 * 1024, 1024, 1024, wl + WOUT, kb * 64, n0, n0, scr, lane); }
    }
    for (int i = gt; i < 2048; i += NGT) ((float*)(a.ws + WS_ONES))[i] = i < 1024 ? 1.f : 0.f;
    for (int i = gt; i < 2 * 28672; i += NGT) { const int l = i / 28672, c = i % 28672;
        *(v4u*)((bf16*)(a.ws + WS_W) + (size_t)l * WL_ELEMS + WIN + (size_t)3104 * 1024 + (size_t)c * 8) = (v4u){0u, 0u, 0u, 0u}; }
    for (int i = gt; i < 2 * 524288; i += NGT) { const int which = i / 524288, c = i % 524288;
        const float* src = (which ? a.in[3] : a.in[2]) + (size_t)c * 8; const f32x4 x0 = *(const f32x4*)src, x1 = *(const f32x4*)(src + 4);
        v4u o; o.x = pk2(x0[0], x0[1]); o.y = pk2(x0[2], x0[3]); o.z = pk2(x1[0], x1[1]); o.w = pk2(x1[2], x1[3]);
        *(v4u*)((bf16*)(a.ws + (which ? WS_CV : WS_CK)) + (size_t)c * 8) = o; }
    __syncthreads();
    float* S = (float*)lds; float* red = (float*)lds + 9 * 1024;
    for (int i = tid; i < 9 * 1024; i += 512) { const int r = i >> 10, k = i & 1023; const float cv = r == 0 ? a.in[6][k] : a.in[5][(r - 1) * 1024 + k]; S[i] = siluf_(cv); }
    __syncthreads();
    float* MOD = (float*)(a.ws + WS_MOD);
    for (int item = BID; item < 288; item += NB) {
        const int l = item / 144, cb = item % 144;
        const float* wp = a.in[7] + (size_t)l * 1024 * 9216 + cb * 64 + lane;
        float acc[9];
#pragma unroll
        for (int r = 0; r < 9; ++r) acc[r] = 0.f;
#pragma unroll 8
        for (int kk = 0; kk < 128; ++kk) { const int k = wave * 128 + kk; const float wv = wp[(size_t)k * 9216];
#pragma unroll
            for (int r = 0; r < 9; ++r) acc[r] += S[r * 1024 + k] * wv; }
#pragma unroll
        for (int r = 0; r < 9; ++r) red[(wave * 9 + r) * 64 + lane] = acc[r];
        __syncthreads();
        for (int i = tid; i < 576; i += 512) { const int r = i >> 6, c = i & 63; float s = 0.f;
#pragma unroll
            for (int w = 0; w < 8; ++w) s += red[(w * 9 + r) * 64 + c];
            MOD[(size_t)(l * 9 + r) * 9216 + cb * 64 + c] = s + a.in[8][l * 9216 + cb * 64 + c]; }
        __syncthreads();
    }
}

__device__ __forceinline__ void phase_rowpass(const Args& a, int mode, int ln_idx, int mod_l, int mod_sub, int lane, int wave, bool dummy = false, int ps_n = 0, int ps_lnprev = -1, int ps_l = 0, int ps_gi = 0, float ps_gs = 0.f) {
    OPQ_IDS();
    const int gw = BID * 8 + wave, NGW = NB * 8;
    bf16* H = (bf16*)(a.ws + (dummy ? WS_UZ : WS_H));
    const bf16* V = (const bf16*)(a.ws + WS_V);
    float* STATS = (float*)(a.ws + WS_STATS);
    const float* MOD = (const float*)(a.ws + WS_MOD);
    for (int m = gw; m < M; m += NGW) {
        f32x4 v[4];
        if (mode == 0) {
            const float* src = m < MPR ? a.in[0] + (size_t)m * D : a.in[1] + (size_t)(m - MPR) * D;
#pragma unroll
            for (int j = 0; j < 2; ++j) { v[2 * j] = *((const f32x4*)src + (64 * j + lane) * 2); v[2 * j + 1] = *((const f32x4*)src + (64 * j + lane) * 2 + 1); }
#pragma unroll
            for (int j = 0; j < 2; ++j) *((v4u*)((bf16*)(a.ws + WS_V) + (size_t)m * D) + 64 * j + lane) = (v4u){pk2(v[2 * j][0], v[2 * j][1]), pk2(v[2 * j][2], v[2 * j][3]), pk2(v[2 * j + 1][0], v[2 * j + 1][1]), pk2(v[2 * j + 1][2], v[2 * j + 1][3])};
            if (lane == 0) { float z_, o_; asm volatile("v_mov_b32 %0, 0\n\tv_mov_b32 %1, 1.0" : "=v"(z_), "=v"(o_)); STATS[2 * m] = z_; STATS[2 * m + 1] = o_; }
        } else {
#pragma unroll
            for (int j = 0; j < 2; ++j) { const v4u w = *((const v4u*)(V + (size_t)m * D) + 64 * j + lane);
                v[2 * j] = (f32x4){bflo(w.x), bfhi(w.x), bflo(w.y), bfhi(w.y)}; v[2 * j + 1] = (f32x4){bflo(w.z), bfhi(w.z), bflo(w.w), bfhi(w.w)}; }
            if (ps_n > 0 && m < MPR) {
                const float* ones = (const float*)(a.ws + WS_ONES);
                const float* lgp = ps_lnprev < 0 ? ones : a.in[24] + ps_lnprev * D; const float* lbp = ps_lnprev < 0 ? ones + D : a.in[25] + ps_lnprev * D;
                const float mo = STATS[2 * m], ro = STATS[2 * m + 1];
                const float* gp = MOD + (size_t)(ps_l * 9) * 9216 + ps_gi * 1024;
                const float* pp = (const float*)(a.ws + WS_PART) + (size_t)m * D;
#pragma unroll
                for (int j = 0; j < 2; ++j)
#pragma unroll
                    for (int q = 0; q < 2; ++q) {
                        const int c4 = (64 * j + lane) * 2 + q;
                        f32x4 ps = *((const f32x4*)pp + c4);
                        for (int s = 1; s < ps_n; ++s) ps += *((const f32x4*)(pp + (size_t)s * PART_SLICE) + c4);
                        const f32x4 x = (v[2 * j + q] - mo) * ro * *((const f32x4*)lgp + c4) + *((const f32x4*)lbp + c4);
                        v[2 * j + q] = x * ALPHA + *((const f32x4*)gp + c4) * ps_gs * ps;
                    }
#pragma unroll
                for (int j = 0; j < 2; ++j) *((v4u*)((bf16*)(a.ws + WS_V) + (size_t)m * D) + 64 * j + lane) = (v4u){pk2(v[2 * j][0], v[2 * j][1]), pk2(v[2 * j][2], v[2 * j][3]), pk2(v[2 * j + 1][0], v[2 * j + 1][1]), pk2(v[2 * j + 1][2], v[2 * j + 1][3])};
            }
            float s = 0.f;
#pragma unroll
            for (int j = 0; j < 4; ++j) s += (v[j][0] + v[j][1]) + (v[j][2] + v[j][3]);
            const float mean = wave_sum(s, lane) * (1.f / D); float s2 = 0.f;
#pragma unroll
            for (int j = 0; j < 4; ++j) { v[j] = v[j] - mean; s2 += (v[j][0] * v[j][0] + v[j][1] * v[j][1]) + (v[j][2] * v[j][2] + v[j][3] * v[j][3]); }
            const float rstd = 1.f / sqrtf(wave_sum(s2, lane) * (1.f / D) + LN_EPS);
            if (mode == 1 && lane == 0 && !dummy) { STATS[2 * m] = mean; STATS[2 * m + 1] = rstd; }
            const float* g = a.in[24] + ln_idx * D; const float* bb = a.in[25] + ln_idx * D;
#pragma unroll
            for (int j = 0; j < 2; ++j)
#pragma unroll
                for (int q = 0; q < 2; ++q) { const f32x4 gv = *((const f32x4*)g + (64 * j + lane) * 2 + q), bv = *((const f32x4*)bb + (64 * j + lane) * 2 + q); v[2 * j + q] = v[2 * j + q] * rstd * gv + bv; }
        }
        if (mode == 2) {
            float* xo = a.out + (size_t)m * D;
#pragma unroll
            for (int j = 0; j < 2; ++j) { *((f32x4*)xo + (64 * j + lane) * 2) = v[2 * j]; *((f32x4*)xo + (64 * j + lane) * 2 + 1) = v[2 * j + 1]; }
        } else {
            const int mrow = m < MPR ? 0 : 1 + ((m - MPR) >> 12);
            const float* mp = MOD + (size_t)(mod_l * 9 + mrow) * 9216 + 3 * mod_sub * 1024;
#pragma unroll
            for (int j = 0; j < 2; ++j) {
                f32x4 h[2];
#pragma unroll
                for (int q = 0; q < 2; ++q) { const f32x4 sh = *((const f32x4*)mp + (64 * j + lane) * 2 + q), sc = *((const f32x4*)(mp + 1024) + (64 * j + lane) * 2 + q); h[q] = v[2 * j + q] * (sc + 1.f) + sh; }
                *((v4u*)(H + (size_t)m * D) + 64 * j + lane) = (v4u){pk2(h[0][0], h[0][1]), pk2(h[0][2], h[0][3]), pk2(h[1][0], h[1][1]), pk2(h[1][2], h[1][3])};
            }
        }
    }
}

__device__ __forceinline__ void conv_item(const Args& a, unsigned char* lds, int l, int tc, int tid, int lane, int wave) {
    int m0, ms0, T; tc_decode(tc, m0, ms0, T);
    const bf16* Z = (const bf16*)(a.ws + WS_UZ);
    bf16* Y = (bf16*)(a.ws + WS_H);
    float* Yl = (float*)lds;
    for (int ch = tid; ch < 94 * 32; ch += 512) {
        const int rr = ch >> 5, c8 = (ch & 31) * 8, mt = m0 - 15 + rr;
        f32x4 y0 = {0.f, 0.f, 0.f, 0.f}, y1 = y0;
        if (mt >= ms0 && mt < ms0 + T) {
            const v4u av = *(const v4u*)(Z + (size_t)mt * NZ + c8), gv = *(const v4u*)(Z + (size_t)mt * NZ + 256 + c8);
            y0[0] = bflo(av.x) * sigmoidf_(bflo(gv.x)); y0[1] = bfhi(av.x) * sigmoidf_(bfhi(gv.x));
            y0[2] = bflo(av.y) * sigmoidf_(bflo(gv.y)); y0[3] = bfhi(av.y) * sigmoidf_(bfhi(gv.y));
            y1[0] = bflo(av.z) * sigmoidf_(bflo(gv.z)); y1[1] = bfhi(av.z) * sigmoidf_(bfhi(gv.z));
            y1[2] = bflo(av.w) * sigmoidf_(bflo(gv.w)); y1[3] = bfhi(av.w) * sigmoidf_(bfhi(gv.w));
        }
        *(f32x4*)(Yl + rr * 256 + c8) = y0; *(f32x4*)(Yl + rr * 256 + c8 + 4) = y1;
    }
    __syncthreads();
    {
        const int c = tid & 255, half = tid >> 8;
        float w[31];
#pragma unroll
        for (int j = 0; j < 31; ++j) w[j] = a.in[14][(size_t)(l * 31 + j) * 256 + c];
        const float bias = a.in[15][l * 256 + c];
        for (int tt = 0; tt < 32; ++tt) {
            const int tl = half * 32 + tt; float acc = bias;
#pragma unroll
            for (int j = 0; j < 31; ++j) acc += w[j] * Yl[(tl + j) * 256 + c];
            Yl[(half ? 94 + tt : tl) * 256 + c] = acc;
        }
    }
    __syncthreads();
    {
        const f32x4 g = *((const f32x4*)(a.in[16] + l * 256) + lane), bb = *((const f32x4*)(a.in[17] + l * 256) + lane);
#pragma unroll
        for (int q = 0; q < 8; ++q) {
            const int tl = wave * 8 + q, rix = tl < 32 ? tl : 94 + (tl - 32);
            f32x4 x = *((const f32x4*)(Yl + rix * 256) + lane);
            const float mean = wave_sum((x[0] + x[1]) + (x[2] + x[3]), lane) * (1.f / 256.f);
            x = x - mean;
            const float rstd = 1.f / sqrtf(wave_sum((x[0] * x[0] + x[1] * x[1]) + (x[2] * x[2] + x[3] * x[3]), lane) * (1.f / 256.f) + LN_EPS);
            x = x * rstd * g + bb;
            v2u wv; wv.x = pk2(siluf_(x[0]), siluf_(x[1])); wv.y = pk2(siluf_(x[2]), siluf_(x[3]));
            *((v2u*)(Y + (size_t)(m0 + tl) * D) + lane) = wv;
        }
    }
    __syncthreads();
}

template <int NG>
__device__ __forceinline__ void gla_cumsum_pre(const float (&wa)[16], float ba, int d, int grp, int dk, const float* lrS, float* G) {
    constexpr int TG = 64 / NG;
    {
        float run = 0.f;
#pragma unroll 4
        for (int ii = 0; ii < TG; ++ii) {
            const int i = grp * TG + (d == 0 ? ii : TG - 1 - ii);
            float x = ba;
#pragma unroll
            for (int r = 0; r < 16; ++r) x += lrS[i * 32 + 16 * d + r] * wa[r];
            run += logsig(x) * (1.f / 16.f);
            G[i * 68 + dk] = run;
        }
    }
    __syncthreads();
    float off = 0.f;
    if (d == 0) { for (int g = 0; g < grp; ++g) off += G[(g * TG + TG - 1) * 68 + dk]; }
    else { for (int g = grp + 1; g < NG; ++g) off += G[(g * TG) * 68 + dk]; }
    __syncthreads();
#pragma unroll 4
    for (int ii = 0; ii < TG; ++ii) G[(grp * TG + ii) * 68 + dk] += off;
    __syncthreads();
}
template <int NG>
__device__ __forceinline__ void gla_cumsum(const Args& a, int l, int h, int d, int grp, bool active, int dk, const float* lrS, float* G) {
    constexpr int TG = 64 / NG;
    if (active) {
        float wa[16];
#pragma unroll
        for (int r = 0; r < 16; ++r) wa[r] = a.in[18][(size_t)((l * 2 + d) * 16 + r) * 256 + h * 64 + dk];
        const float ba = a.in[19][(l * 2 + d) * 256 + h * 64 + dk];
        float run = 0.f;
#pragma unroll 4
        for (int ii = 0; ii < TG; ++ii) {
            const int i = grp * TG + (d == 0 ? ii : TG - 1 - ii);
            float x = ba;
#pragma unroll
            for (int r = 0; r < 16; ++r) x += lrS[i * 32 + 16 * d + r] * wa[r];
            run += logsig(x) * (1.f / 16.f);
            G[i * 68 + dk] = run;
        }
    }
    __syncthreads();
    float off = 0.f;
    if (active) {
        if (d == 0) { for (int g = 0; g < grp; ++g) off += G[(g * TG + TG - 1) * 68 + dk]; }
        else { for (int g = grp + 1; g < NG; ++g) off += G[(g * TG) * 68 + dk]; }
    }
    __syncthreads();
    if (active) {
#pragma unroll 4
        for (int ii = 0; ii < TG; ++ii) G[(grp * TG + ii) * 68 + dk] += off;
    }
    __syncthreads();
}

#if !GLA_MFMA
__device__ __forceinline__ void gla_g1_item(const Args& a, unsigned char* lds, int l, int item, int tid) {
    const int tc = item >> 2, h = item & 3;
    int m0, ms0, T; tc_decode(tc, m0, ms0, T);
    const bf16* Z = (const bf16*)(a.ws + WS_UZ);
    const float* LR = (const float*)(a.ws + WS_LR);
    float* KVS = a.out; float* DEC = (float*)(a.ws + WS_DEC);
    float* lrS = (float*)lds; float* Gf = lrS + 2048; float* Gb = Gf + 4352; float* kS = Gb + 4352; float* vS = kS + 4352; float* KH = vS + 4352;
    *((f32x4*)lrS + tid) = *((const f32x4*)(LR + (size_t)m0 * 32) + tid);
    {
        const int i = tid >> 3, c8 = (tid & 7) * 8;
        const v4u kv = *(const v4u*)(Z + (size_t)(m0 + i) * NZ + ZC_GK + h * 64 + c8), vv = *(const v4u*)(Z + (size_t)(m0 + i) * NZ + ZC_GV + h * 64 + c8);
        float* kp = kS + i * 68 + c8; float* vp = vS + i * 68 + c8;
        *(f32x4*)kp = (f32x4){bflo(kv.x), bfhi(kv.x), bflo(kv.y), bfhi(kv.y)}; *(f32x4*)(kp + 4) = (f32x4){bflo(kv.z), bfhi(kv.z), bflo(kv.w), bfhi(kv.w)};
        *(f32x4*)vp = (f32x4){bflo(vv.x), bfhi(vv.x), bflo(vv.y), bfhi(vv.y)}; *(f32x4*)(vp + 4) = (f32x4){bflo(vv.z), bfhi(vv.z), bflo(vv.w), bfhi(vv.w)};
    }
    __syncthreads();
    {
        const int w = tid >> 6, d = w >> 2;
        gla_cumsum<4>(a, l, h, d, w & 3, true, tid & 63, lrS, d == 0 ? Gf : Gb);
    }
    for (int e = tid; e < 8192; e += 512) {
        const int d = e >> 12, i = (e >> 6) & 63, dk = e & 63;
        const float* G = d == 0 ? Gf : Gb; const float glast = d == 0 ? Gf[63 * 68 + dk] : Gb[dk];
        KH[d * 4352 + i * 68 + dk] = kS[i * 68 + dk] * __expf(glast - G[i * 68 + dk]);
    }
    if (tid < 128) { const int d = tid >> 6, dk = tid & 63; const float glast = d == 0 ? Gf[63 * 68 + dk] : Gb[dk];
        DEC[(size_t)((tc * 4 + h) * 2 + d) * 64 + dk] = __expf(glast); }
    __syncthreads();
    {
        const int d = tid >> 8, t2 = tid & 255, dk0 = (t2 >> 4) * 4, dv0 = (t2 & 15) * 4;
        const float* kh = KH + d * 4352;
        f32x4 acc[4];
#pragma unroll
        for (int x = 0; x < 4; ++x) acc[x] = (f32x4){0.f, 0.f, 0.f, 0.f};
#pragma unroll 4
        for (int s = 0; s < 64; ++s) { const f32x4 ka = *(const f32x4*)(kh + s * 68 + dk0), vb = *(const f32x4*)(vS + s * 68 + dv0);
#pragma unroll
            for (int x = 0; x < 4; ++x) acc[x] += ka[x] * vb; }
        float* o = KVS + (size_t)((tc * 4 + h) * 2 + d) * 4096;
#pragma unroll
        for (int x = 0; x < 4; ++x) *(f32x4*)(o + (dk0 + x) * 64 + dv0) = acc[x];
    }
    __syncthreads();
}

#endif
__device__ __forceinline__ void gla_scan(const Args& a, int l, int tid, size_t woff = 0) {
    OPQ_IDS();
    float* KVS = a.out; const float* DEC = (const float*)(a.ws + WS_DEC);
    const int gt = BID * 512 + tid, NGT = NB * 512;
    for (int task = gt; task < 65536; task += NGT) {
        const int e = (task & 1023) * 4, d = (task >> 10) & 1, h = (task >> 11) & 3, b = task >> 13;
        const int pdk = 16 * (e >> 10) + 4 * ((e >> 6) & 3), pdv = 16 * ((e >> 8) & 3) + ((e >> 2) & 15);
        const float* s0 = a.in[4] + (size_t)(((b * 2 + l) * 2 + d) * 4 + h) * 4096 + pdk * 64 + pdv;
        f32x4 S = {s0[0], s0[64], s0[128], s0[192]};
        const int base = 64 + b * 64;
        for (int n0 = 0; n0 < 64; n0 += 8) {
            f32x4 kvv[8], dd[8]; float* p[8];
#pragma unroll
            for (int u = 0; u < 8; ++u) { const int n = n0 + u, tc = d == 0 ? base + n : base + 63 - n; const size_t idx = (size_t)((tc * 4 + h) * 2 + d);
                p[u] = KVS + idx * 4096 + e; kvv[u] = *(const f32x4*)p[u]; dd[u] = *(const f32x4*)(DEC + idx * 64 + pdk); }
#pragma unroll
            for (int u = 0; u < 8; ++u) { *(f32x4*)(p[u] + woff) = S; S = dd[u] * S + kvv[u]; }
        }
    }
    for (int task = gt; task < 131072; task += NGT) {
        const int e = (task & 1023) * 4, d = (task >> 10) & 1, h = (task >> 11) & 3, b = task >> 13;
        const int pdk = 16 * (e >> 10) + 4 * ((e >> 6) & 3), pdv = 16 * ((e >> 8) & 3) + ((e >> 2) & 15);
        f32x4 S = {0.f, 0.f, 0.f, 0.f}; const int base = b * 4;
        f32x4 kvv[4], dd[4]; float* p[4];
#pragma unroll
        for (int u = 0; u < 4; ++u) { const int tc = d == 0 ? base + u : base + 3 - u; const size_t idx = (size_t)((tc * 4 + h) * 2 + d);
            p[u] = KVS + idx * 4096 + e; kvv[u] = *(const f32x4*)p[u]; dd[u] = *(const f32x4*)(DEC + idx * 64 + pdk); }
#pragma unroll
        for (int u = 0; u < 4; ++u) { *(f32x4*)(p[u] + woff) = S; S = dd[u] * S + kvv[u]; }
        if (woff == 0) { float* o = a.out + OUT_G + (size_t)(((b * 2 + l) * 2 + d) * 4 + h) * 4096 + pdk * 64 + pdv; o[0] = S[0]; o[64] = S[1]; o[128] = S[2]; o[192] = S[3]; }
    }
}

#if !GLA_MFMA
__device__ __forceinline__ void gla_g3_item(const Args& a, unsigned char* lds, int l, int item, int tid) {
    const int tc = item >> 2, h = item & 3;
    int m0, ms0, T; tc_decode(tc, m0, ms0, T);
    const bf16* Z = (const bf16*)(a.ws + WS_UZ);
    const float* LR = (const float*)(a.ws + WS_LR);
    const float* KVS = a.out;
    bf16* Y = (bf16*)(a.ws + WS_H);
    float* lrS = (float*)lds; float* vS = lrS + 2048; float* GA = vS + 4352; float* QT = GA + 4352; float* KT = QT + 4352; float* SS = KT + 4352;
    *((f32x4*)lrS + tid) = *((const f32x4*)(LR + (size_t)m0 * 32) + tid);
    {
        const int i = tid >> 3, c8 = (tid & 7) * 8;
        const v4u vv = *(const v4u*)(Z + (size_t)(m0 + i) * NZ + ZC_GV + h * 64 + c8);
        float* vp = vS + i * 68 + c8;
        *(f32x4*)vp = (f32x4){bflo(vv.x), bfhi(vv.x), bflo(vv.y), bfhi(vv.y)}; *(f32x4*)(vp + 4) = (f32x4){bflo(vv.z), bfhi(vv.z), bflo(vv.w), bfhi(vv.w)};
    }
    __syncthreads();
    const int ib = tid >> 4, jb = tid & 15, dv0 = jb * 4;
    f32x4 o[2];
    o[0] = (f32x4){0.f, 0.f, 0.f, 0.f}; o[1] = o[0];
    for (int d = 0; d < 2; ++d) {
        gla_cumsum<8>(a, l, h, d, tid >> 6, true, tid & 63, lrS, GA);
        {
            const int i = tid >> 3, c8 = (tid & 7) * 8;
            const v4u qv = *(const v4u*)(Z + (size_t)(m0 + i) * NZ + ZC_GQ + h * 64 + c8), kv = *(const v4u*)(Z + (size_t)(m0 + i) * NZ + ZC_GK + h * 64 + c8);
            const float qq[8] = {bflo(qv.x), bfhi(qv.x), bflo(qv.y), bfhi(qv.y), bflo(qv.z), bfhi(qv.z), bflo(qv.w), bfhi(qv.w)};
            const float kk[8] = {bflo(kv.x), bfhi(kv.x), bflo(kv.y), bfhi(kv.y), bflo(kv.z), bfhi(kv.z), bflo(kv.w), bfhi(kv.w)};
#pragma unroll
            for (int e = 0; e < 8; ++e) { const float g = GA[i * 68 + c8 + e]; QT[i * 68 + c8 + e] = qq[e] * __expf(g); KT[i * 68 + c8 + e] = kk[e] * __expf(-g); }
            const float* sp = KVS + (size_t)((tc * 4 + h) * 2 + d) * 4096;
#pragma unroll
            for (int x = 0; x < 2; ++x) { const int f = tid + 512 * x, dk = f >> 4, dv4 = (f & 15) * 4; *(f32x4*)(SS + dk * 68 + dv4) = *(const f32x4*)(sp + dk * 64 + dv4); }
        }
        __syncthreads();
        {
            float acc[2][4];
#pragma unroll
            for (int ii = 0; ii < 2; ++ii)
#pragma unroll
                for (int jj = 0; jj < 4; ++jj) acc[ii][jj] = 0.f;
#pragma unroll 4
            for (int k4 = 0; k4 < 16; ++k4) {
                f32x4 qa[2], kb[4];
#pragma unroll
                for (int ii = 0; ii < 2; ++ii) qa[ii] = *(const f32x4*)(QT + (ib + 32 * ii) * 68 + 4 * k4);
#pragma unroll
                for (int jj = 0; jj < 4; ++jj) kb[jj] = *(const f32x4*)(KT + (jb + 16 * jj) * 68 + 4 * k4);
#pragma unroll
                for (int ii = 0; ii < 2; ++ii)
#pragma unroll
                    for (int jj = 0; jj < 4; ++jj) acc[ii][jj] += (qa[ii][0] * kb[jj][0] + qa[ii][1] * kb[jj][1]) + (qa[ii][2] * kb[jj][2] + qa[ii][3] * kb[jj][3]);
            }
#pragma unroll
            for (int ii = 0; ii < 2; ++ii)
#pragma unroll
                for (int jj = 0; jj < 4; ++jj) { const int i = ib + 32 * ii, j = jb + 16 * jj; const bool keep = d == 0 ? (j <= i) : (j >= i); GA[i * 68 + j] = keep ? acc[ii][jj] : 0.f; }
        }
        __syncthreads();
        {
#pragma unroll 2
            for (int j4 = 0; j4 < 16; ++j4) {
                f32x4 av[2];
#pragma unroll
                for (int ii = 0; ii < 2; ++ii) av[ii] = *(const f32x4*)(GA + (ib + 32 * ii) * 68 + 4 * j4);
#pragma unroll
                for (int jj = 0; jj < 4; ++jj) { const f32x4 vv = *(const f32x4*)(vS + (4 * j4 + jj) * 68 + dv0); o[0] += av[0][jj] * vv; o[1] += av[1][jj] * vv; }
            }
#pragma unroll 2
            for (int k4 = 0; k4 < 16; ++k4) {
                f32x4 qv[2];
#pragma unroll
                for (int ii = 0; ii < 2; ++ii) qv[ii] = *(const f32x4*)(QT + (ib + 32 * ii) * 68 + 4 * k4);
#pragma unroll
                for (int x = 0; x < 4; ++x) { const f32x4 sv = *(const f32x4*)(SS + (4 * k4 + x) * 68 + dv0); o[0] += qv[0][x] * sv; o[1] += qv[1][x] * sv; }
            }
        }
        __syncthreads();
    }
    const f32x4 gn = *(const f32x4*)(a.in[20] + l * 64 + dv0);
#pragma unroll
    for (int ii = 0; ii < 2; ++ii) {
        const int i = ib + 32 * ii;
        float ss = (o[ii][0] * o[ii][0] + o[ii][1] * o[ii][1]) + (o[ii][2] * o[ii][2] + o[ii][3] * o[ii][3]);
        ss += shx(ss, 1, tid & 63); ss += shx(ss, 2, tid & 63); ss += shx(ss, 4, tid & 63); ss += shx(ss, 8, tid & 63);
        const float rstd = 1.f / sqrtf(ss * (1.f / 64.f) + LN_EPS);
        const v2u gw = *(const v2u*)(Z + (size_t)(m0 + i) * NZ + ZC_GG + h * 64 + dv0);
        const f32x4 y = o[ii] * rstd * gn;
        v2u w; w.x = pk2(y[0] * siluf_(bflo(gw.x)), y[1] * siluf_(bfhi(gw.x))); w.y = pk2(y[2] * siluf_(bflo(gw.y)), y[3] * siluf_(bfhi(gw.y)));
        *(v2u*)(Y + (size_t)(m0 + i) * D + 256 + h * 64 + dv0) = w;
    }
}

#else
__device__ __forceinline__ unsigned f2bf1(float f) { const unsigned u = __float_as_uint(f); return (u + 0x7fffu + ((u >> 16) & 1u)) >> 16; }
__device__ __forceinline__ f32x4 mfma16(bf16x8 a, bf16x8 b, f32x4 c) { return __builtin_amdgcn_mfma_f32_16x16x32_bf16(a, b, c, 0, 0, 0); }
__device__ __forceinline__ void gla_build_vt(const bf16* Z, int m0, int h, bf16* VT, int tid) {
    const int dv = tid & 63, jg = tid >> 6;
    const bf16* vp = Z + (size_t)(m0 + 8 * jg) * NZ + ZC_GV + h * 64 + dv;
    unsigned e[8];
#pragma unroll
    for (int x = 0; x < 8; ++x) e[x] = vp[(size_t)x * NZ];
    *(v4u*)(VT + dv * 72 + 8 * jg) = (v4u){e[0] | (e[1] << 16), e[2] | (e[3] << 16), e[4] | (e[5] << 16), e[6] | (e[7] << 16)};
}
__device__ __forceinline__ void gla_g1_item(const Args& a, unsigned char* lds, int l, int item, int tid) {
    const int tc = item >> 2, h = item & 3;
    int m0, ms0, T; tc_decode(tc, m0, ms0, T);
    const bf16* Z = (const bf16*)(a.ws + WS_UZ);
    const float* LR = (const float*)(a.ws + WS_LR);
    float* KVS = a.out; float* DEC = (float*)(a.ws + WS_DEC);
    float* lrS = (float*)lds; float* Gf = (float*)(lds + 8192); float* Gb = (float*)(lds + 25600);
    bf16* KHT = (bf16*)(lds + 43008); bf16* VT = (bf16*)(lds + 61440);
    const int lane = tid & 63, w = tid >> 6, l16 = lane & 15, lq = lane >> 4;
    unsigned kx[8];
    { const bf16* kp = Z + (size_t)(m0 + 8 * w) * NZ + ZC_GK + h * 64 + lane;
#pragma unroll
      for (int x = 0; x < 8; ++x) kx[x] = kp[(size_t)x * NZ]; }
    float wa[16];
    const int dcs = w >> 2;
#pragma unroll
    for (int r = 0; r < 16; ++r) wa[r] = a.in[18][(size_t)((l * 2 + dcs) * 16 + r) * 256 + h * 64 + lane];
    const float ba = a.in[19][(l * 2 + dcs) * 256 + h * 64 + lane];
    *((f32x4*)lrS + tid) = *((const f32x4*)(LR + (size_t)m0 * 32) + tid);
    gla_build_vt(Z, m0, h, VT, tid);
    __syncthreads();
    gla_cumsum_pre<4>(wa, ba, dcs, w & 3, lane, lrS, dcs == 0 ? Gf : Gb);
#pragma unroll
    for (int d = 0; d < 2; ++d) {
        const int dk = lane, sg = w;
        const float* G = d == 0 ? Gf : Gb; const float glast = d == 0 ? Gf[63 * 68 + dk] : Gb[dk];
        unsigned e[8];
#pragma unroll
        for (int x = 0; x < 8; ++x) e[x] = f2bf1(bf2f((unsigned short)kx[x]) * __expf(glast - G[(8 * sg + x) * 68 + dk]));
        *(v4u*)(KHT + d * 4608 + dk * 72 + 8 * sg) = (v4u){e[0] | (e[1] << 16), e[2] | (e[3] << 16), e[4] | (e[5] << 16), e[6] | (e[7] << 16)};
    }
    if (tid < 128) { const int d = tid >> 6, dk = tid & 63; const float glast = d == 0 ? Gf[63 * 68 + dk] : Gb[dk];
        DEC[(size_t)((tc * 4 + h) * 2 + d) * 64 + dk] = __expf(glast); }
    __syncthreads();
    {
        const int d = w >> 2, mt = w & 3;
        float* o = KVS + (size_t)((tc * 4 + h) * 2 + d) * 4096;
        bf16x8 af[2];
#pragma unroll
        for (int ks = 0; ks < 2; ++ks) af[ks] = *(const bf16x8*)(KHT + d * 4608 + (16 * mt + l16) * 72 + 32 * ks + 8 * lq);
#pragma unroll
        for (int nt = 0; nt < 4; ++nt) {
            f32x4 acc = {0.f, 0.f, 0.f, 0.f};
#pragma unroll
            for (int ks = 0; ks < 2; ++ks) acc = mfma16(af[ks], *(const bf16x8*)(VT + (16 * nt + l16) * 72 + 32 * ks + 8 * lq), acc);
            *(f32x4*)(o + ((mt * 4 + nt) * 64 + lane) * 4) = acc;
        }
    }
    __syncthreads();
}
__device__ __forceinline__ void gla_g3_item(const Args& a, unsigned char* lds, int l, int item, int tid) {
    const int tc = item >> 2, h = item & 3;
    int m0, ms0, T; tc_decode(tc, m0, ms0, T);
    const bf16* Z = (const bf16*)(a.ws + WS_UZ);
    const float* LR = (const float*)(a.ws + WS_LR);
    const float* KVS = a.out;
    bf16* Y = (bf16*)(a.ws + WS_H);
    const int lane = tid & 63, w = tid >> 6, l16 = lane & 15, lq = lane >> 4, d = w >> 2, mt = w & 3, td = tid & 255;
    float* lrS = (float*)lds; bf16* VT = (bf16*)(lds + 8192);
    unsigned char* db = lds + 17408 + d * 54272;
    float* GA = (float*)db; bf16* QT = (bf16*)(db + 17408); bf16* KT = (bf16*)(db + 26624); bf16* PB = (bf16*)(db + 35840); bf16* ST = (bf16*)(db + 45056);
    float* OX = (float*)(lds + 17408 + 54272);
    const int qi = td >> 2, c16 = (td & 3) * 16;
    v4u qv2[2], kv2[2];
    { const bf16* qp = Z + (size_t)(m0 + qi) * NZ + ZC_GQ + h * 64 + c16; const bf16* kp = Z + (size_t)(m0 + qi) * NZ + ZC_GK + h * 64 + c16;
      qv2[0] = *(const v4u*)qp; qv2[1] = *(const v4u*)(qp + 8); kv2[0] = *(const v4u*)kp; kv2[1] = *(const v4u*)(kp + 8); }
    const int sdv = td & 63, skg = td >> 6;
    f32x4 s4[4];
    { const float* sp = KVS + (size_t)((tc * 4 + h) * 2 + d) * 4096 + ((skg * 4 + (sdv >> 4)) * 64 + (sdv & 15)) * 4;
#pragma unroll
      for (int q4 = 0; q4 < 4; ++q4) s4[q4] = *(const f32x4*)(sp + q4 * 64); }
    float wa[16];
#pragma unroll
    for (int r = 0; r < 16; ++r) wa[r] = a.in[18][(size_t)((l * 2 + d) * 16 + r) * 256 + h * 64 + lane];
    const float ba = a.in[19][(l * 2 + d) * 256 + h * 64 + lane];
    unsigned gx[4][4];
    if (d == 0) {
#pragma unroll
        for (int j = 0; j < 4; ++j)
#pragma unroll
            for (int nt = 0; nt < 4; ++nt) gx[j][nt] = Z[(size_t)(m0 + 16 * mt + 4 * lq + j) * NZ + ZC_GG + h * 64 + 16 * nt + l16];
    }
    *((f32x4*)lrS + tid) = *((const f32x4*)(LR + (size_t)m0 * 32) + tid);
    gla_build_vt(Z, m0, h, VT, tid);
    __syncthreads();
    gla_cumsum_pre<4>(wa, ba, d, mt, lane, lrS, GA);
    {
        const int i = qi;
#pragma unroll
        for (int hf = 0; hf < 2; ++hf) {
            const v4u qv = qv2[hf], kv = kv2[hf];
            const float qq[8] = {bflo(qv.x), bfhi(qv.x), bflo(qv.y), bfhi(qv.y), bflo(qv.z), bfhi(qv.z), bflo(qv.w), bfhi(qv.w)};
            const float kk[8] = {bflo(kv.x), bfhi(kv.x), bflo(kv.y), bfhi(kv.y), bflo(kv.z), bfhi(kv.z), bflo(kv.w), bfhi(kv.w)};
            float qo[8], ko[8];
#pragma unroll
            for (int e = 0; e < 8; ++e) { const float g = GA[i * 68 + c16 + 8 * hf + e]; qo[e] = qq[e] * __expf(g); ko[e] = kk[e] * __expf(-g); }
            *(v4u*)(QT + i * 72 + c16 + 8 * hf) = (v4u){pk2(qo[0], qo[1]), pk2(qo[2], qo[3]), pk2(qo[4], qo[5]), pk2(qo[6], qo[7])};
            *(v4u*)(KT + i * 72 + c16 + 8 * hf) = (v4u){pk2(ko[0], ko[1]), pk2(ko[2], ko[3]), pk2(ko[4], ko[5]), pk2(ko[6], ko[7])};
        }
        *(v4u*)(ST + sdv * 72 + 16 * skg) = (v4u){pk2(s4[0][0], s4[0][1]), pk2(s4[0][2], s4[0][3]), pk2(s4[1][0], s4[1][1]), pk2(s4[1][2], s4[1][3])};
        *(v4u*)(ST + sdv * 72 + 16 * skg + 8) = (v4u){pk2(s4[2][0], s4[2][1]), pk2(s4[2][2], s4[2][3]), pk2(s4[3][0], s4[3][1]), pk2(s4[3][2], s4[3][3])};
    }
    __syncthreads();
    {
        bf16x8 af[2];
#pragma unroll
        for (int ks = 0; ks < 2; ++ks) af[ks] = *(const bf16x8*)(QT + (16 * mt + l16) * 72 + 32 * ks + 8 * lq);
#pragma unroll
        for (int nt = 0; nt < 4; ++nt) {
            f32x4 p = {0.f, 0.f, 0.f, 0.f};
#pragma unroll
            for (int ks = 0; ks < 2; ++ks) p = mfma16(af[ks], *(const bf16x8*)(KT + (16 * nt + l16) * 72 + 32 * ks + 8 * lq), p);
#pragma unroll
            for (int j = 0; j < 4; ++j) { const int i = 16 * mt + 4 * lq + j, jc = 16 * nt + l16; const bool keep = d == 0 ? (jc <= i) : (jc >= i);
                PB[i * 72 + jc] = (bf16)f2bf1(keep ? p[j] : 0.f); }
        }
    }
    __syncthreads();
    f32x4 acc[4];
#pragma unroll
    for (int nt = 0; nt < 4; ++nt) acc[nt] = (f32x4){0.f, 0.f, 0.f, 0.f};
#pragma unroll
    for (int ks = 0; ks < 4; ++ks) {
        const bf16x8 af = *(const bf16x8*)((ks < 2 ? PB : QT) + (16 * mt + l16) * 72 + 32 * (ks & 1) + 8 * lq);
#pragma unroll
        for (int nt = 0; nt < 4; ++nt) acc[nt] = mfma16(af, *(const bf16x8*)((ks < 2 ? VT : ST) + (16 * nt + l16) * 72 + 32 * (ks & 1) + 8 * lq), acc[nt]);
    }
    if (d == 1) {
#pragma unroll
        for (int nt = 0; nt < 4; ++nt)
#pragma unroll
            for (int j = 0; j < 4; ++j) OX[(16 * mt + 4 * lq + j) * 68 + 16 * nt + l16] = acc[nt][j];
    }
    __syncthreads();
    if (d == 0) {
#pragma unroll
        for (int j = 0; j < 4; ++j) {
            const int i = 16 * mt + 4 * lq + j;
            float s = 0.f;
#pragma unroll
            for (int nt = 0; nt < 4; ++nt) { acc[nt][j] += OX[i * 68 + 16 * nt + l16]; s += acc[nt][j] * acc[nt][j]; }
            s += shx(s, 1, lane); s += shx(s, 2, lane); s += shx(s, 4, lane); s += shx(s, 8, lane);
            const float rstd = 1.f / sqrtf(s * (1.f / 64.f) + LN_EPS);
#pragma unroll
            for (int nt = 0; nt < 4; ++nt) {
                const int dv = 16 * nt + l16;
                const float gate = bf2f((unsigned short)gx[j][nt]);
                ((bf16*)(lds + 8192))[i * 72 + dv] = (bf16)f2bf1(acc[nt][j] * rstd * a.in[20][l * 64 + dv] * siluf_(gate));
            }
        }
    }
    __syncthreads();
    { const int r = tid >> 3, c = tid & 7; *(v4u*)(Y + (size_t)(m0 + r) * D + 256 + h * 64 + c * 8) = *(const v4u*)(lds + 8192 + r * 144 + c * 16); }
    __syncthreads();
}
#endif
typedef short v4i16_t __attribute__((ext_vector_type(4)));
typedef LAS const char* lds_cptr;
__device__ __forceinline__ s16x4 vtr(lds_cptr p) { return __builtin_bit_cast(s16x4, __builtin_amdgcn_ds_read_tr16_b64_v4i16((LAS v4i16_t*)p)); }
__device__ __forceinline__ float half_swap_max(float m) { auto rr = __builtin_amdgcn_permlane32_swap(__float_as_uint(m), __float_as_uint(m), false, false); return fmaxf(__uint_as_float(rr[0]), __uint_as_float(rr[1])); }
__device__ __forceinline__ float half_swap_sum(float m) { auto rr = __builtin_amdgcn_permlane32_swap(__float_as_uint(m), __float_as_uint(m), false, false); return __uint_as_float(rr[0]) + __uint_as_float(rr[1]); }
constexpr int KST = 272, VST = 320, KBUFB = 64 * KST, VBUFB = 64 * VST, OXS = 132;

__device__ __forceinline__ void attn_item(const Args& a, unsigned char* lds, int l, bool sample, int b, int h, int qblk, float lam, float oscale, int tid, int lane, int wave) {
    const bf16* Z = (const bf16*)(a.ws + WS_UZ);
    bf16* Y = (bf16*)(a.ws + WS_H);
    const int mseq0 = sample ? MPR + b * 4096 : b * 256;
    const int nNew = sample ? 64 : 4, NT = sample ? 72 : 4;
    const bf16* ck = (const bf16*)(a.ws + WS_CK) + (size_t)(((b * 2 + l) * 4 + h) * 512) * 128;
    const bf16* cv = (const bf16*)(a.ws + WS_CV) + (size_t)(((b * 2 + l) * 4 + h) * 512) * 128;
    const int mp = wave >> 2, qs = wave & 3, q32 = lane & 31, hh = lane >> 5;
    const int mq = mseq0 + qblk * 128 + qs * 32 + q32;
    bf16x8 qf[4];
    { const bf16* qp = Z + (size_t)mq * NZ + ZC_DQ + h * 128 + mp * 64 + hh * 8;
#pragma unroll
      for (int s = 0; s < 4; ++s) qf[s] = *(const bf16x8*)(qp + 16 * s); }
    unsigned char* Kb0 = lds; unsigned char* Vb0 = lds + 2 * KBUFB;
    const int lrow = tid >> 4, lch = tid & 15;
    v4u kr[2], vr[2];
#define ATT_LOADX(dst, kt, zc, cbase) do { _Pragma("unroll") for (int i_ = 0; i_ < 2; ++i_) { const int row_ = lrow + 32 * i_; \
        if ((kt) < nNew) dst[i_] = *(const v4u*)(Z + (size_t)(mseq0 + (kt) * 64 + row_) * NZ + h * 128 + lch * 8 + (zc)); \
        else dst[i_] = *(const v4u*)((cbase) + (size_t)(((kt) - nNew) * 64 + row_) * 128 + lch * 8); } } while (0)
#define ATT_STOREK(buf) do { _Pragma("unroll") for (int i_ = 0; i_ < 2; ++i_) *(v4u*)(Kb0 + (buf) * KBUFB + (lrow + 32 * i_) * KST + lch * 16) = kr[i_]; } while (0)
#define ATT_STOREV(buf) do { _Pragma("unroll") for (int i_ = 0; i_ < 2; ++i_) *(v4u*)(Vb0 + (buf) * VBUFB + (lrow + 32 * i_) * VST + lch * 16) = vr[i_]; } while (0)
    ATT_LOADX(kr, 0, ZC_DK, ck); ATT_STOREK(0);
    __syncthreads();
    f32x16 O[4];
#pragma unroll
    for (int i = 0; i < 4; ++i)
#pragma unroll
        for (int r = 0; r < 16; ++r) O[i][r] = 0.f;
    float mref = 0.f, lrun = 0.f;
    f32x16 negm;
    { float z_; asm volatile("v_mov_b32 %0, 0" : "=v"(z_));
#pragma unroll
      for (int r = 0; r < 16; ++r) negm[r] = z_; }
    asm volatile("" : "+v"(negm));
    const int koff = q32 * KST + (mp * 64 + hh * 8) * 2;
    const int voff = (4 * hh + ((lane & 15) >> 2)) * VST + (16 * ((lane >> 4) & 1) + 4 * (lane & 3)) * 2;
    bf16x8 pk[4];
#pragma unroll
    for (int i = 0; i < 4; ++i) pk[i] = (bf16x8){0, 0, 0, 0, 0, 0, 0, 0};
    f32x16 st0, st1;
    float fsc = 1.f, ps = 0.f; bool resc = false;
#define ATT_QKDEC(kt_) do { const unsigned char* Kb = Kb0 + ((kt_) & 1) * KBUFB + koff; \
        bf16x8 ka_[4], kb_[4]; \
        _Pragma("unroll") for (int s = 0; s < 4; ++s) { ka_[s] = *(const bf16x8*)(Kb + s * 32); kb_[s] = *(const bf16x8*)(Kb + 32 * KST + s * 32); } \
        __builtin_amdgcn_sched_barrier(0);              \
        _Pragma("unroll") for (int s = 0; s < 4; ++s) { \
            if (s == 0) { st0 = __builtin_amdgcn_mfma_f32_32x32x16_bf16(ka_[s], qf[s], negm, 0, 0, 0); st1 = __builtin_amdgcn_mfma_f32_32x32x16_bf16(kb_[s], qf[s], negm, 0, 0, 0); } \
            else { st0 = __builtin_amdgcn_mfma_f32_32x32x16_bf16(ka_[s], qf[s], st0, 0, 0, 0); st1 = __builtin_amdgcn_mfma_f32_32x32x16_bf16(kb_[s], qf[s], st1, 0, 0, 0); } } \
        float mx = fmaxf(st0[0], st1[0]); \
        _Pragma("unroll") for (int r = 1; r < 16; ++r) mx = fmaxf(fmaxf(mx, st0[r]), st1[r]); \
        mx = half_swap_max(mx); \
        fsc = 1.f; resc = false; \
        if ((kt_) == 0 || __any(mx > 8.f)) {        \
            const float delta = (kt_) == 0 ? mx : fmaxf(mx, 0.f); \
            mref += delta; fsc = __builtin_amdgcn_exp2f(-delta); resc = true; \
            _Pragma("unroll") for (int r = 0; r < 16; ++r) { st0[r] -= delta; st1[r] -= delta; } \
            _Pragma("unroll") for (int r = 0; r < 16; ++r) negm[r] = -mref; \
            asm volatile("" : "+v"(negm)); \
        } } while (0)
#define ATT_EXPQ(S, r0) do { _Pragma("unroll") for (int r = 0; r < 8; ++r) { S[(r0) + r] = __builtin_amdgcn_exp2f(S[(r0) + r]); ps += S[(r0) + r]; } } while (0)
#define ATT_PVG(Vb_, ks) do { _Pragma("unroll") for (int blk = 0; blk < 4; ++blk) { \
            const s16x4 lo = vtr(Vb_ + ((ks) * 16) * VST + blk * 64), hi = vtr(Vb_ + ((ks) * 16 + 8) * VST + blk * 64); \
            const bf16x8 vf = (bf16x8){lo[0], lo[1], lo[2], lo[3], hi[0], hi[1], hi[2], hi[3]}; \
            O[blk] = __builtin_amdgcn_mfma_f32_32x32x16_bf16(vf, pk[ks], O[blk], 0, 0, 0); } } while (0)
#define ATT_FIN() do { lrun = lrun * fsc + ps; \
        if (resc) { _Pragma("unroll") for (int i = 0; i < 4; ++i) _Pragma("unroll") for (int r = 0; r < 16; ++r) O[i][r] *= fsc; } \
        pk[0] = __builtin_bit_cast(bf16x8, (v4u){pk2(st0[0], st0[1]), pk2(st0[2], st0[3]), pk2(st0[4], st0[5]), pk2(st0[6], st0[7])}); \
        pk[1] = __builtin_bit_cast(bf16x8, (v4u){pk2(st0[8], st0[9]), pk2(st0[10], st0[11]), pk2(st0[12], st0[13]), pk2(st0[14], st0[15])}); \
        pk[2] = __builtin_bit_cast(bf16x8, (v4u){pk2(st1[0], st1[1]), pk2(st1[2], st1[3]), pk2(st1[4], st1[5]), pk2(st1[6], st1[7])}); \
        pk[3] = __builtin_bit_cast(bf16x8, (v4u){pk2(st1[8], st1[9]), pk2(st1[10], st1[11]), pk2(st1[12], st1[13]), pk2(st1[14], st1[15])}); } while (0)
    ATT_LOADX(kr, 1, ZC_DK, ck); ATT_LOADX(vr, 0, ZC_DV, cv);
    ATT_QKDEC(0);
    ps = 0.f; ATT_EXPQ(st0, 0); ATT_EXPQ(st0, 8); ATT_EXPQ(st1, 0); ATT_EXPQ(st1, 8);
    ATT_FIN();
    ATT_STOREK(1); ATT_STOREV(0);
    __syncthreads();
    for (int kt = 1; kt < NT; ++kt) {
        if (kt + 1 < NT) ATT_LOADX(kr, kt + 1, ZC_DK, ck);
        ATT_LOADX(vr, kt, ZC_DV, cv);
        ATT_QKDEC(kt);
        { const lds_cptr Vb = (lds_cptr)(Vb0 + ((kt - 1) & 1) * VBUFB) + voff;
          ps = 0.f;
          s16x4 nlo[6], nhi[6];
#pragma unroll
          for (int f_ = 0; f_ < 6; ++f_) { nlo[f_] = vtr(Vb + ((f_ >> 2) * 16) * VST + (f_ & 3) * 64); nhi[f_] = vtr(Vb + ((f_ >> 2) * 16 + 8) * VST + (f_ & 3) * 64); }
          __builtin_amdgcn_sched_barrier(0);
#pragma unroll
          for (int i_ = 0; i_ < 16; ++i_) {
              const int ks = i_ >> 2, blk = i_ & 3, sl = i_ % 6;
              const bf16x8 vf = (bf16x8){nlo[sl][0], nlo[sl][1], nlo[sl][2], nlo[sl][3], nhi[sl][0], nhi[sl][1], nhi[sl][2], nhi[sl][3]};
              O[blk] = __builtin_amdgcn_mfma_f32_32x32x16_bf16(vf, pk[ks], O[blk], 0, 0, 0);
              if (i_ + 6 < 16) { const int n_ = i_ + 6; nlo[sl] = vtr(Vb + ((n_ >> 2) * 16) * VST + (n_ & 3) * 64); nhi[sl] = vtr(Vb + ((n_ >> 2) * 16 + 8) * VST + (n_ & 3) * 64); }
              if (i_ < 8) { float e0 = __builtin_amdgcn_exp2f(st0[2 * i_]), e1 = __builtin_amdgcn_exp2f(st0[2 * i_ + 1]); ps += e0 + e1;
                  asm volatile("" : "+v"(e0), "+v"(e1), "+v"(ps));
                  st0[2 * i_] = e0; st0[2 * i_ + 1] = e1; }
              else { float e0 = __builtin_amdgcn_exp2f(st1[2 * i_ - 16]), e1 = __builtin_amdgcn_exp2f(st1[2 * i_ - 15]); ps += e0 + e1;
                  asm volatile("" : "+v"(e0), "+v"(e1), "+v"(ps));
                  st1[2 * i_ - 16] = e0; st1[2 * i_ - 15] = e1; }
              __builtin_amdgcn_sched_barrier(0);
          } }
        ATT_FIN();
        if (kt + 1 < NT) ATT_STOREK((kt + 1) & 1);
        ATT_STOREV(kt & 1);
        __syncthreads();
    }
    { const lds_cptr Vb = (lds_cptr)(Vb0 + ((NT - 1) & 1) * VBUFB) + voff;
      ATT_PVG(Vb, 0); ATT_PVG(Vb, 1); ATT_PVG(Vb, 2); ATT_PVG(Vb, 3); }
    __syncthreads();
#undef ATT_QKDEC
#undef ATT_EXPQ
#undef ATT_PVG
#undef ATT_FIN
#undef ATT_LOADX
#undef ATT_STOREK
#undef ATT_STOREV
    const float inv = 1.f / half_swap_sum(lrun);
    float* Ox = (float*)lds;
    const int qrow = qs * 32 + q32;
    if (mp == 0) {
#pragma unroll
        for (int blk = 0; blk < 4; ++blk)
#pragma unroll
            for (int g = 0; g < 4; ++g) *(f32x4*)(Ox + qrow * OXS + blk * 32 + 8 * g + 4 * hh) = (f32x4){O[blk][4 * g] * inv, O[blk][4 * g + 1] * inv, O[blk][4 * g + 2] * inv, O[blk][4 * g + 3] * inv};
    }
    __syncthreads();
    if (mp == 1) {
        float ss = 0.f; const float li = lam * inv;
#pragma unroll
        for (int blk = 0; blk < 4; ++blk)
#pragma unroll
            for (int g = 0; g < 4; ++g) { const f32x4 o1 = *(const f32x4*)(Ox + qrow * OXS + blk * 32 + 8 * g + 4 * hh);
#pragma unroll
                for (int e = 0; e < 4; ++e) { const float o = o1[e] - li * O[blk][4 * g + e]; O[blk][4 * g + e] = o; ss += o * o; } }
        ss = half_swap_sum(ss);
        const float rs = oscale / sqrtf(ss * (1.f / 128.f) + LN_EPS);
        const float* gn = a.in[22] + l * 128;
#pragma unroll
        for (int blk = 0; blk < 4; ++blk)
#pragma unroll
            for (int g = 0; g < 4; ++g) { const int dv = blk * 32 + 8 * g + 4 * hh; const f32x4 gv = *(const f32x4*)(gn + dv);
                v2u w; w.x = pk2(O[blk][4 * g] * rs * gv[0], O[blk][4 * g + 1] * rs * gv[1]); w.y = pk2(O[blk][4 * g + 2] * rs * gv[2], O[blk][4 * g + 3] * rs * gv[3]);
                *(v2u*)(lds + 67584 + qrow * 272 + dv * 2) = w; }
    }
    __syncthreads();
    {
        const int mblk = mseq0 + qblk * 128;
#pragma unroll
        for (int i = 0; i < 4; ++i) { const int ch = tid + 512 * i, r = ch >> 4, c = ch & 15;
            *(v4u*)(Y + (size_t)(mblk + r) * D + 512 + h * 128 + c * 8) = *(const v4u*)(lds + 67584 + r * 272 + c * 16); }
    }
    __syncthreads();
}

__device__ __forceinline__ void phase_attn(const Args& a, unsigned char* lds, int l, int tid, int lane, int wave) {
    OPQ_IDS();
    const float* lp = a.in[21] + l * 256;
    const float s1 = wave_sum(lp[lane] * lp[64 + lane], lane), s2 = wave_sum(lp[128 + lane] * lp[192 + lane], lane);
    const float lam_init = 0.8f - 0.6f * expf(-0.3f * (float)l);
    const float lam = expf(s1) - expf(s2) + lam_init;
    for (int p = BID; p < 1024; p += NB) {
        const int pair = (p >> 8) * 8 + (p & 7), qblk = (p & 255) >> 3;
        attn_item(a, lds, l, true, pair >> 2, pair & 3, qblk, lam, 1.f - lam_init, tid, lane, wave);
    }
    for (int p = BID; p < 128; p += NB) {
        const int pair = p >> 1;
        attn_item(a, lds, l, false, pair >> 2, pair & 3, p & 1, lam, 1.f - lam_init, tid, lane, wave);
    }
}

#define XB_TMO      128
#define XB_XCNT(j)  (256  + 64 * (j))
#define XB_XSUB(j)  (1280 + 64 * (j))
#define XB_XGEN(j)  (2304 + 64 * (j))
#define XB_TOP      3328
#define XB_TOPGEN   3392
#define XCD_BAR_WORDS 3456
#define XB_SPIN_CAP (1u << 18)

__device__ __forceinline__ unsigned xb_ld(unsigned* p)              { return __hip_atomic_load(p, __ATOMIC_RELAXED, __HIP_MEMORY_SCOPE_AGENT); }
__device__ __forceinline__ unsigned xb_add(unsigned* p, unsigned v) { return __hip_atomic_fetch_add(p, v, __ATOMIC_RELAXED, __HIP_MEMORY_SCOPE_AGENT); }
__device__ __forceinline__ unsigned xb_xcc_id() { return (unsigned)__builtin_amdgcn_s_getreg((3 << 11) | 20) & 0xFu; }
#define XB_SPIN(cond, bar) do { unsigned _sp = 0; while (cond) { __builtin_amdgcn_s_sleep(1); \
    if ((++_sp & 255u) == 0u) { if (xb_ld(&(bar)[XB_TMO])) break; if (_sp > XB_SPIN_CAP) { atomicAdd(&(bar)[XB_TMO], 1u); break; } } } } while (0)

struct XcdBarrier {
    unsigned* bar; unsigned x;
    volatile LAS unsigned* st;
};

__device__ __forceinline__ XcdBarrier xcd_barrier_post(unsigned* bar, volatile LAS unsigned* st) {
    XcdBarrier b; b.bar = bar; b.x = xb_xcc_id(); b.st = st;
    if (threadIdx.x == 0) (void)xb_add(&bar[XB_XCNT(b.x)], 1u);
    return b;
}
__device__ __forceinline__ void xcd_barrier_complete(unsigned* bar, unsigned x, unsigned& nloc, unsigned& nx) {
    const unsigned G = gridDim.x * gridDim.y * gridDim.z;
    unsigned sum, cnt, mine, sp = 0u;
    for (;;) {
        sum = 0u; cnt = 0u; mine = 0u;
#pragma unroll
        for (unsigned j = 0; j < 16; ++j) { const unsigned c = xb_ld(&bar[XB_XCNT(j)]); sum += c; cnt += (c > 0u) ? 1u : 0u; mine = (j == x) ? c : mine; }
        if (sum == G) break;
        __builtin_amdgcn_s_sleep(1);
        if ((++sp & 255u) == 0u) { if (xb_ld(&bar[XB_TMO])) break; if (sp > XB_SPIN_CAP) { atomicAdd(&bar[XB_TMO], 1u); break; } }
    }
    nloc = mine > 0u ? mine : 1u; nx = cnt > 0u ? cnt : 1u;
}

__device__ __forceinline__ void xcd_barrier(const XcdBarrier& b) {
    asm volatile("s_waitcnt vmcnt(0)" ::: "memory");
    __syncthreads();
    if (threadIdx.x == 0) {
        unsigned* bar = b.bar;
        __builtin_amdgcn_s_waitcnt(0);
        unsigned nloc = b.st[0], nx = b.st[1];
        if (nloc == 0u) { xcd_barrier_complete(bar, b.x, nloc, nx); b.st[0] = nloc; b.st[1] = nx; }
        const unsigned old = xb_add(&bar[XB_XSUB(b.x)], 1u);
        const unsigned gen = old / nloc;
        if (old + 1u == (gen + 1u) * nloc) {
            __builtin_amdgcn_fence(__ATOMIC_RELEASE, "agent");
            asm volatile("s_waitcnt vmcnt(0)" ::: "memory");
            const unsigned og = xb_add(&bar[XB_TOP], 1u);
            const unsigned tg = og / nx;
            if (og + 1u == (tg + 1u) * nx) xb_add(&bar[XB_TOPGEN], 1u);
            else XB_SPIN(xb_ld(&bar[XB_TOPGEN]) == tg, bar);
            __builtin_amdgcn_fence(__ATOMIC_ACQUIRE, "agent");
            xb_add(&bar[XB_XGEN(b.x)], 1u);
            asm volatile("s_waitcnt vmcnt(0)" ::: "memory");
        } else {
            XB_SPIN(xb_ld(&bar[XB_XGEN(b.x)]) == gen, bar);
            __builtin_amdgcn_fence(__ATOMIC_ACQUIRE, "agent");
            asm volatile("s_waitcnt vmcnt(0)" ::: "memory");
        }
    }
    __syncthreads();
}

template <int PHMT>
__global__ void __launch_bounds__(512, 2) fwd_kernel_t(Args a_) {
#undef PHM
#define PHM PHMT
    extern __shared__ __attribute__((aligned(16))) unsigned char lds[];
    cg::grid_group grid = cg::this_grid();
    const int ph_lo = a_.ph_lo, ph_hi = a_.ph_hi, coop = a_.coop;
    volatile LAS unsigned* stw = (volatile LAS unsigned*)((LAS unsigned char*)lds + 131072 + 256);
    if (threadIdx.x < 2) stw[threadIdx.x] = 0u;
    __syncthreads();
    if (coop) (void)xcd_barrier_post((unsigned*)a_.ws, stw);
    for (int ph = ph_lo; ph < ph_hi; ++ph) {
        const __attribute__((address_space(4))) Args* ap = (const __attribute__((address_space(4))) Args*)__builtin_amdgcn_kernarg_segment_ptr();
        asm volatile("" : "+s"(ap));
        const Args& a = *(const Args*)ap;
        OPQ_IDS();
        int tid = threadIdx.x; asm volatile("" : "+v"(tid));
        const int lane = tid & 63, wave = __builtin_amdgcn_readfirstlane(tid >> 6);
        if (ph == 0) { for (int rep = 0; rep < ((PROBE & 64) ? 2 : 1); ++rep) if (PHM & 1) phase_prologue(a, lds, tid, lane, wave); }
        else if (ph == 25) { if (PHM & 2) phase_rowpass(a, 2, 5, 0, 0, lane, wave, false, NB == 256 ? KSPLIT : 0, 4, 1, 8, 0.5f); }
        else {
            const int l = (ph - 1) / 12, st = (ph - 1) % 12;
            if ((PHM & 2) && (st == 0 || st == 3 || st == 9)) {
                const int sub = st == 0 ? 0 : (st == 3 ? 1 : 2);
                const int psn = NB == 256 ? KSPLIT : 0;
                if (st == 0) phase_rowpass(a, l == 0 ? 0 : 1, (l - 1) * 3 + 2, l, 0, lane, wave, false, l == 0 ? 0 : psn, 1, 0, 8, 0.5f);
                else phase_rowpass(a, 1, l * 3 + sub - 1, l, sub, lane, wave, false, psn, l * 3 + sub - 2, l, sub == 1 ? 2 : 5, sub == 1 ? 0.5f : 1.f);
                if ((PROBE & 256) && (st != 0 || l == 1)) phase_rowpass(a, 1, st == 0 ? (l - 1) * 3 + 2 : l * 3 + sub - 1, l, sub, lane, wave, true);
            } else if ((PHM & 4) && (st == 1 || st == 2 || st == 4 || st == 8 || st == 10 || st == 11)) {
                const int kind = (st == 1 || st == 10) ? 0 : (st == 4 ? 2 : 1);
                const bf16* A = (st == 2 || st == 11) ? (const bf16*)(a.ws + WS_UZ) : (const bf16*)(a.ws + WS_H);
                const bf16* Bt = (const bf16*)(a.ws + WS_W) + (size_t)l * WL_ELEMS + (st == 1 ? W1I : st == 2 ? W1O : st == 4 ? WIN : st == 8 ? WOUT : st == 10 ? W2I : W2O);
                const int N = kind == 0 ? 2 * DFF : (kind == 2 ? NZ : D), K = (st == 2 || st == 11) ? DFF : D;
                pg8::Gemm g{A, Bt, M, N, K}; pg8::StaticOrder S; S.init(M, N, K, NB, (int)BID); if (kind == 1 && NB == 256) S.nsplit = KSPLIT;
                const int nrep = (((PROBE & 1) && kind == 0) || ((PROBE & 2) && kind == 2) || ((PROBE & 512) && kind == 1)) ? 2 : 1;
                for (int rep = 0; rep < nrep; ++rep) {
                    pg8::EpiAny E{a, (kind == 1 && rep == 1) ? 3 : kind, l, st == 2 ? 2 : (st == 8 ? 5 : 8), st == 8 ? 1.f : 0.5f, l * 3 + (st == 2 ? 0 : (st == 8 ? 1 : 2)) - 1};
                    pg8::gemm_phase<pg8::EpiAny, pg8::StaticOrder, true, true>((PG8_LAS unsigned char*)lds, g, S, E);
                }
            } else if ((PHM & 32) && st == 5) {
                for (int rep = 0; rep < ((PROBE & 4) ? 2 : 1); ++rep)
                    for (int it = BID; it < NTC * 4; it += NB) gla_g1_item(a, lds, l, it, tid);
            } else if ((PHM & 64) && st == 6) {
                gla_scan(a, l, tid);
                if (PROBE & 128) gla_scan(a, l, tid, (size_t)18874368);
                for (int rep = 0; rep < ((PROBE & 8) ? 2 : 1); ++rep)
                    for (int tc = BID; tc < NTC; tc += NB) conv_item(a, lds, l, tc, tid, lane, wave);
            } else if (st == 7) {
                for (int rep = 0; rep < ((PROBE & 16) ? 2 : 1); ++rep)
                    if (PHM & 128) phase_attn(a, lds, l, tid, lane, wave);
                for (int rep = 0; rep < ((PROBE & 32) ? 2 : 1); ++rep)
                    if (PHM & 256) for (int it = BID; it < NTC * 4; it += NB) gla_g3_item(a, lds, l, it, tid);
            }
        }
        if (coop && ph + 1 < ph_hi) {
            if (ph == 0 || !FAST_BAR) grid.sync();
            else { XcdBarrier xb; xb.bar = (unsigned*)a.ws; xb.x = xb_xcc_id(); xb.st = stw; xcd_barrier(xb); if (PROBE & 1024) { xcd_barrier(xb); xcd_barrier(xb); } }
        }
    }
}

#undef PHM
#if MK_PER_PHASE
static int phase_mask(int ph) {
    if (ph == 0) return 1; if (ph == 25) return 2;
    const int st = (ph - 1) % 12;
    if (st == 0 || st == 3 || st == 9) return 2;
    if (st == 5) return 32; if (st == 6) return 64; if (st == 7) return 128 | 256;
    return 4;
}
#define KFN(m) ((const void*)fwd_kernel_t<m>)
#else
#define KFN(m) ((const void*)fwd_kernel_t<0xFFFF>)
#endif
extern "C" void kernel_launch(void* const* d_in, const int* in_sizes, int n_in, void* d_out, int out_size, void* d_ws, size_t ws_size, hipStream_t stream) {
    static int grid = 0;
    if (grid == 0) {
        if (n_in != 26 || ws_size < WS_END) { fprintf(stderr, "kernel_launch: unexpected n_in %d / ws_size %zu (need %zu)\n", n_in, ws_size, (size_t)WS_END); grid = -1; return; }
        int dev = 0, cus = 0;
        (void)hipGetDevice(&dev); (void)hipDeviceGetAttribute(&cus, hipDeviceAttributeMultiprocessorCount, dev);
#if MK_PER_PHASE
        const void* fns[6] = {KFN(1), KFN(2), KFN(4), KFN(32), KFN(64), KFN(384)};
        for (int i = 0; i < 6; ++i) if (hipFuncSetAttribute(fns[i], hipFuncAttributeMaxDynamicSharedMemorySize, LDS_BYTES) != hipSuccess) { fprintf(stderr, "kernel_launch: hipFuncSetAttribute failed\n"); grid = -1; return; }
#else
        if (hipFuncSetAttribute(KFN(0), hipFuncAttributeMaxDynamicSharedMemorySize, LDS_BYTES) != hipSuccess) { fprintf(stderr, "kernel_launch: hipFuncSetAttribute failed\n"); grid = -1; return; }
        int per_cu = 0;
        if (hipOccupancyMaxActiveBlocksPerMultiprocessor(&per_cu, KFN(0), 512, LDS_BYTES) != hipSuccess || per_cu < 1) fprintf(stderr, "kernel_launch: occupancy query gave %d\n", per_cu);
#endif
        (void)hipGetLastError();
        grid = cus > 0 ? cus : 256;
    }
    if (grid < 0) return;
    Args a{};
    for (int i = 0; i < 26; ++i) a.in[i] = (const float*)d_in[i];
    a.out = (float*)d_out; a.ws = (unsigned char*)d_ws; a.pad = 0;
#if MK_PER_PHASE
    for (int ph = 0; ph < 26; ++ph) {
        a.ph_lo = ph; a.ph_hi = ph + 1; a.coop = 0;
        void* args[] = {&a};
        const int m = phase_mask(ph);
        const void* fn = m == 1 ? KFN(1) : m == 2 ? KFN(2) : m == 4 ? KFN(4) : m == 32 ? KFN(32) : m == 64 ? KFN(64) : KFN(384);
        hipError_t e = hipLaunchKernel(fn, dim3(grid), dim3(512), args, LDS_BYTES, stream);
        if (e != hipSuccess) { fprintf(stderr, "launch %d failed: %s\n", ph, hipGetErrorString(e)); break; }
    }
#else
    a.ph_lo = 0; a.ph_hi = 26; a.coop = 1;
    (void)hipMemsetAsync(d_ws, 0, 16384, stream);
    void* args[] = {&a};
    hipError_t e = hipLaunchCooperativeKernel(KFN(0), dim3(grid), dim3(512), args, LDS_BYTES, stream);
    if (e != hipSuccess) fprintf(stderr, "cooperative launch failed: %s (grid %d)\n", hipGetErrorString(e), grid);
#endif
}
```

```cpp
#include <hip/hip_runtime.h>
#include <hip/hip_cooperative_groups.h>
#include <cstdio>
#include <cstdint>
namespace cg = cooperative_groups;
#ifndef MK_PER_PHASE
#define MK_PER_PHASE 0
#endif
#ifndef PHM
#define PHM 0xFFFF
#endif
#ifndef PROBE
#define PROBE 0
#endif
#ifndef GLA_MFMA
#define GLA_MFMA 1
#endif
#ifndef FAST_BAR
#define FAST_BAR 1
#endif
#ifndef KSPLIT
#define KSPLIT 2
#endif
namespace pg8 {
#define PG8_LAS __attribute__((address_space(3)))
typedef unsigned short bf16_t;
typedef short bf16x8 __attribute__((ext_vector_type(8)));
typedef float f32x4 __attribute__((ext_vector_type(4)));
typedef unsigned u32x4 __attribute__((ext_vector_type(4)));
constexpr int BM = 256, BK = 64, HALF = 128, HTB = HALF * BK * 2  , STAGE_BYTES = 8 * HTB, NXCD = 8, WGM = 4;

__host__ __device__ __forceinline__ int lds_byte(int r, int c) { const int st = (r >> 4) * 2 + (c >> 5), rr = r & 15, cc = c & 31, ob = rr * 64 + cc * 2; return st * 1024 + (ob ^ (((ob >> 9) & 1) << 5)); }
__host__ __device__ __forceinline__ void stage_rc(int b, int& R, int& C) { const int st = b / 1024, sb = b % 1024, swz = sb ^ (((sb >> 9) & 1) << 5); R = (st >> 1) * 16 + swz / 64; C = (st & 1) * 32 + (swz % 64) / 2; }
__host__ __device__ __forceinline__ int perm32(int rho) { const int n = rho >> 4, i = rho & 15; return 8 * (i >> 2) + 4 * n + (i & 3); }

struct Unit { int pm, pn, kt0, nkt, split; };
struct Gemm { const bf16_t* A; const bf16_t* Bt; int M, N, K; };

struct StaticOrder {
    int nM, nN, nwg, G, c, ntk, nsplit, rev;
    __host__ __device__ void init(int M, int N, int K, int G_, int c_) { nM = M / BM; nN = N / BM; nwg = nM * nN; G = G_; c = c_; ntk = K / BK; nsplit = 0; rev = 0; }
    __host__ __device__ void map(int wgid, int nwgv, int nMv, Unit& u) const {
        { const int q = nwgv / NXCD, r = nwgv % NXCD, xcd = wgid % NXCD, off = wgid / NXCD; wgid = (xcd < r ? xcd * (q + 1) : r * (q + 1) + (xcd - r) * q) + off; }
        const int nig = WGM * nN, gid = wgid / nig, fm = gid * WGM, gsz = (nMv - fm) < WGM ? (nMv - fm) : WGM;
        u.pm = fm + ((wgid % nig) % gsz); u.pn = (wgid % nig) / gsz;
    }
    __host__ __device__ bool next(int i, Unit& u) const {
        u.kt0 = 0; u.nkt = ntk; u.split = -1;
        if (nsplit > 0) {
            const int nS = (nM - 16) * nN, fullr = nS / G;
            if (i < fullr) { map(i * G + c, nS, nM - 16, u); u.pm = 16 + (rev ? (nM - 17 - u.pm) : u.pm); return true; }
            if (i > fullr || c >= 16 * nN * nsplit) return false;
            const int un = c / nsplit; u.split = c % nsplit; u.pm = un / nN; u.pn = un % nN; u.nkt = ntk / nsplit; u.kt0 = u.split * u.nkt; return true;
        }
        const long L = (long)i * G + c; if (L >= nwg) return false;
        map((int)L, nwg, nM, u); return true;
    }
    __device__ __forceinline__ void a_ready(const Unit&) const {}
    __device__ __forceinline__ void done(const Unit&) const {}
};

__device__ __forceinline__ unsigned cvt_pk_bf16(float lo, float hi) { unsigned r; asm volatile("v_cvt_pk_bf16_f32 %0, %1, %2" : "=v"(r) : "v"(lo), "v"(hi)); return r; }
typedef float f32x2 __attribute__((ext_vector_type(2)));
typedef unsigned u32x2v __attribute__((ext_vector_type(2)));
template <class Epi, class Sched, bool ALIGN_EPI = false, bool SP2 = false>
__device__ __forceinline__ void gemm_phase(PG8_LAS unsigned char* lds, const Gemm g, const Sched& S, const Epi& E) {
    int tid_ = threadIdx.x; asm volatile("" : "+v"(tid_)); const int tid = tid_, wid = __builtin_amdgcn_readfirstlane(tid >> 6), lane = tid & 63, wr = wid >> 2, wc = wid & 3, fr = lane & 15, fq = lane >> 4;
    const int K = g.K, nt = K / BK;
    unsigned voffA[2], voffB[2];
#pragma unroll
    for (int i = 0; i < 2; ++i) { int R, C; stage_rc(tid * 16 + i * 8192, R, C); const int Rb = E.perm() ? ((R & ~31) + perm32(R & 31)) : R;
        voffA[i] = (unsigned)(R * K + C) * 2u; voffB[i] = (unsigned)(Rb * K + C) * 2u; }
    const size_t kstep = (size_t)(BK * 2);
    const size_t hstep = (size_t)HALF * K * 2;
    const size_t tstep = 2 * hstep;
    const unsigned ldsw = (unsigned)wid * 1024u;
    const int aoff = lds_byte(wr * 64 + fr, fq * 8), boff = lds_byte(wc * 32 + fr, fq * 8);
#define PG8_SA(b, h) (((b) * 2 + (h)) * HTB)
#define PG8_SB(b, h) ((4 + (b) * 2 + (h)) * HTB)
#define PG8_STAGE(bufoff, gbase, voff) do { _Pragma("unroll") for (int _i = 0; _i < 2; ++_i) \
        __builtin_amdgcn_global_load_lds((const unsigned*)((const char*)(gbase) + (voff)[_i]), (PG8_LAS unsigned*)(lds + (bufoff) + ldsw + _i * 8192), 16, 0, 0); } while (0)
#define PG8_LDA(dst, b, h) do { _Pragma("unroll") for (int m = 0; m < 4; ++m) _Pragma("unroll") for (int k = 0; k < 2; ++k) dst[m][k] = *(const PG8_LAS bf16x8*)(lds + PG8_SA(b, h) + aoff + m * 2048 + k * 1024); } while (0)
#define PG8_LDB(dst, b, h) do { _Pragma("unroll") for (int n = 0; n < 2; ++n) _Pragma("unroll") for (int k = 0; k < 2; ++k) dst[n][k] = *(const PG8_LAS bf16x8*)(lds + PG8_SB(b, h) + boff + n * 2048 + k * 1024); } while (0)
#define PG8_MMA(ai, bj, At, Bt) do { __builtin_amdgcn_s_setprio(1); _Pragma("unroll") for (int m = 0; m < 4; ++m) _Pragma("unroll") for (int n = 0; n < 2; ++n) _Pragma("unroll") for (int k = 0; k < 2; ++k) \
        acc[ai][bj][m][n] = __builtin_amdgcn_mfma_f32_16x16x32_bf16(Bt[n][k], At[m][k], acc[ai][bj][m][n], 0, 0, 0); __builtin_amdgcn_s_setprio(0); } while (0)
#define PG8_WAIT_V(n) asm volatile("s_waitcnt vmcnt(" #n ")" ::: "memory")
#define PG8_WAIT_L(n) asm volatile("s_waitcnt lgkmcnt(" #n ")" ::: "memory")
#define PG8_BAR __builtin_amdgcn_s_barrier()
#define PG8_SCHED __builtin_amdgcn_sched_barrier(0)
    Unit cur, nxt; int ui = 0;
    if (!S.next(0, cur)) return;
    f32x4 acc[2][2][4][2];
#pragma unroll
    for (int a = 0; a < 2; ++a)
#pragma unroll
        for (int b = 0; b < 2; ++b)
#pragma unroll
            for (int m = 0; m < 4; ++m)
#pragma unroll
                for (int n = 0; n < 2; ++n) acc[a][b][m][n] = (f32x4){0.f, 0.f, 0.f, 0.f};
    bf16x8 At[4][2], B0[2][2], B1[2][2];
    const char* cA = (const char*)g.A + (size_t)cur.pm * tstep + (size_t)cur.kt0 * kstep; const char* cB = (const char*)g.Bt + (size_t)cur.pn * tstep + (size_t)cur.kt0 * kstep;
    S.a_ready(cur);
    if constexpr (SP2) {
        PG8_STAGE(PG8_SB(0, 0), cB, voffB); PG8_STAGE(PG8_SB(0, 1), cB + hstep, voffB); PG8_STAGE(PG8_SA(0, 0), cA, voffA); PG8_STAGE(PG8_SA(0, 1), cA + hstep, voffA);
        if (wr == 1) PG8_BAR;
        PG8_WAIT_V(2); PG8_BAR;
        PG8_STAGE(PG8_SB(1, 0), cB + kstep, voffB); PG8_STAGE(PG8_SA(1, 0), cA + kstep, voffA); PG8_STAGE(PG8_SB(1, 1), cB + hstep + kstep, voffB);
        PG8_WAIT_V(6); PG8_BAR;
    } else {
        PG8_STAGE(PG8_SB(0, 0), cB, voffB); PG8_STAGE(PG8_SA(0, 0), cA, voffA); PG8_STAGE(PG8_SB(0, 1), cB + hstep, voffB); PG8_STAGE(PG8_SA(0, 1), cA + hstep, voffA);
        if (wr == 1) PG8_BAR;
        PG8_WAIT_V(4); PG8_BAR;
        PG8_STAGE(PG8_SB(1, 0), cB + kstep, voffB); PG8_STAGE(PG8_SA(1, 0), cA + kstep, voffA); PG8_STAGE(PG8_SB(1, 1), cB + hstep + kstep, voffB);
        PG8_WAIT_V(6); PG8_BAR;
    }
    for (;;) {
        const bool has_next = S.next(ui + 1, nxt);
        const char* nA = has_next ? (const char*)g.A + (size_t)nxt.pm * tstep + (size_t)nxt.kt0 * kstep : cA; const char* nB = has_next ? (const char*)g.Bt + (size_t)nxt.pn * tstep + (size_t)nxt.kt0 * kstep : cB;
        const int ntu = cur.nkt;
        for (int t = 0; t < ntu; t += 2) {
            const bool last = (t == ntu - 2);
            const char* a1 = cA + (size_t)(t + 1) * kstep;
            const char* a2 = last ? nA : cA + (size_t)(t + 2) * kstep; const char* b2 = last ? nB : cB + (size_t)(t + 2) * kstep;
            const char* a3 = a2 + kstep; const char* b3 = b2 + kstep;
            if (last && has_next) S.a_ready(nxt);
            if constexpr (SP2) {
            PG8_LDB(B0, 0, 0); PG8_LDB(B1, 0, 1); PG8_SCHED; PG8_LDA(At, 0, 0); PG8_STAGE(PG8_SA(1, 1), a1 + hstep, voffA);
            PG8_WAIT_V(8); PG8_WAIT_L(0); PG8_BAR; PG8_MMA(0, 0, At, B0); PG8_MMA(0, 1, At, B1); PG8_BAR; PG8_SCHED;
            PG8_LDA(At, 0, 1); PG8_STAGE(PG8_SB(0, 0), b2, voffB); PG8_STAGE(PG8_SB(0, 1), b2 + hstep, voffB); PG8_STAGE(PG8_SA(0, 0), a2, voffA);
            PG8_WAIT_V(8); PG8_WAIT_L(0); PG8_BAR; PG8_MMA(1, 0, At, B0); PG8_MMA(1, 1, At, B1); PG8_BAR; PG8_SCHED;
            PG8_LDB(B0, 1, 0); PG8_LDB(B1, 1, 1); PG8_SCHED; PG8_LDA(At, 1, 0); PG8_STAGE(PG8_SA(0, 1), a2 + hstep, voffA);
            PG8_WAIT_V(8); PG8_WAIT_L(0); PG8_BAR; PG8_MMA(0, 0, At, B0); PG8_MMA(0, 1, At, B1); PG8_BAR; PG8_SCHED;
            PG8_LDA(At, 1, 1); PG8_STAGE(PG8_SB(1, 0), b3, voffB); PG8_STAGE(PG8_SB(1, 1), b3 + hstep, voffB); PG8_STAGE(PG8_SA(1, 0), a3, voffA);
            PG8_WAIT_V(8); PG8_WAIT_L(0); PG8_BAR; PG8_MMA(1, 0, At, B0); PG8_MMA(1, 1, At, B1); PG8_BAR; PG8_SCHED;
            } else {
            PG8_LDB(B0, 0, 0); PG8_SCHED; PG8_LDA(At, 0, 0); PG8_STAGE(PG8_SA(1, 1), a1 + hstep, voffA);
            PG8_WAIT_L(8); PG8_BAR; PG8_WAIT_L(0); PG8_MMA(0, 0, At, B0); PG8_BAR; PG8_SCHED;
            PG8_LDB(B1, 0, 1); PG8_STAGE(PG8_SB(0, 0), b2, voffB);
            PG8_BAR; PG8_WAIT_L(0); PG8_MMA(0, 1, At, B1); PG8_BAR;
            PG8_LDA(At, 0, 1); PG8_STAGE(PG8_SA(0, 0), a2, voffA);
            PG8_BAR; PG8_WAIT_L(0); PG8_MMA(1, 0, At, B0); PG8_BAR; PG8_SCHED;
            PG8_STAGE(PG8_SB(0, 1), b2 + hstep, voffB);
            PG8_WAIT_V(6); PG8_BAR; PG8_MMA(1, 1, At, B1); PG8_BAR;
            PG8_LDB(B0, 1, 0); PG8_SCHED; PG8_LDA(At, 1, 0); PG8_STAGE(PG8_SA(0, 1), a2 + hstep, voffA);
            PG8_WAIT_L(8); PG8_BAR; PG8_WAIT_L(0); PG8_MMA(0, 0, At, B0); PG8_BAR; PG8_SCHED;
            PG8_LDB(B1, 1, 1); PG8_STAGE(PG8_SB(1, 0), b3, voffB);
            PG8_BAR; PG8_WAIT_L(0); PG8_MMA(0, 1, At, B1); PG8_BAR;
            PG8_LDA(At, 1, 1); PG8_STAGE(PG8_SA(1, 0), a3, voffA);
            PG8_BAR; PG8_WAIT_L(0); PG8_MMA(1, 0, At, B0); PG8_BAR; PG8_SCHED;
            PG8_STAGE(PG8_SB(1, 1), b3 + hstep, voffB);
            PG8_WAIT_V(6); PG8_BAR; PG8_MMA(1, 1, At, B1); PG8_BAR;
            }
        }
        if constexpr (ALIGN_EPI) { if (wr == 0) PG8_BAR; }
        if constexpr (!Epi::AFTER_DRAIN) { E(acc, cur, wr, wc, fr, fq); S.done(cur); }
        if (!has_next) break;
#pragma unroll
        for (int a = 0; a < 2; ++a)
#pragma unroll
            for (int b = 0; b < 2; ++b)
#pragma unroll
                for (int m = 0; m < 4; ++m)
#pragma unroll
                    for (int n = 0; n < 2; ++n) acc[a][b][m][n] = (f32x4){0.f, 0.f, 0.f, 0.f};
        cur = nxt; cA = nA; cB = nB; ++ui;
        if constexpr (ALIGN_EPI) { if (wr == 1) PG8_BAR; }
    }
    PG8_WAIT_V(0);
    if constexpr (!ALIGN_EPI) { if (wr == 0) PG8_BAR; }
    PG8_BAR;
    if constexpr (Epi::AFTER_DRAIN) { E.fused(acc, cur, wr, wc, fr, fq, lds, wid, lane); S.done(cur); }
#undef PG8_SA
#undef PG8_SB
#undef PG8_STAGE
#undef PG8_LDA
#undef PG8_LDB
#undef PG8_MMA
#undef PG8_WAIT_V
#undef PG8_WAIT_L
#undef PG8_BAR
#undef PG8_SCHED
}
}

#define LAS __attribute__((address_space(3)))
typedef unsigned short bf16;
typedef unsigned v4u __attribute__((ext_vector_type(4)));
typedef unsigned v2u __attribute__((ext_vector_type(2)));
typedef float f32x4 __attribute__((ext_vector_type(4)));
typedef float f32x16 __attribute__((ext_vector_type(16)));
typedef short bf16x8 __attribute__((ext_vector_type(8)));
typedef short s16x4 __attribute__((ext_vector_type(4)));

constexpr int D = 1024, MPR = 4096, M = 36864, DFF = 2816, NZ = 3328, NTC = 576;
constexpr int ZC_GQ = 512, ZC_GK = 768, ZC_GV = 1024, ZC_GG = 1280, ZC_DQ = 1536, ZC_DK = 2048, ZC_DV = 2560;
constexpr float ALPHA = 1.41421356237309505f, LN_EPS = 1e-5f;
constexpr size_t MiB = 1u << 20;
constexpr size_t WS_MOD = 1 * MiB, WS_DEC = 2 * MiB, WS_LR = 4 * MiB, WS_CK = 9 * MiB, WS_CV = 17 * MiB, WS_W = 25 * MiB;
constexpr size_t W1I = 0, W1O = 5767168, W2I = 8650752, W2O = 14417920, WIN = 17301504, WOUT = 20709376, WL_ELEMS = 21757952;
constexpr size_t WS_H = 108 * MiB, WS_UZ = 180 * MiB, WS_V = 414 * MiB, WS_END = 486 * MiB, WS_PART = WS_UZ + 198 * MiB, PART_SLICE = (size_t)MPR * D, WS_STATS = 512 * 1024, WS_ONES = 896 * 1024;
constexpr size_t OUT_K = 37748736, OUT_V = 41943040, OUT_G = 46137344;
constexpr int LDS_BYTES = 147456;


#define OPQ_IDS() int BID = blockIdx.x, NB = gridDim.x; asm volatile("" : "+s"(BID), "+s"(NB))
struct Args { const float* in[26]; float* out; unsigned char* ws; int ph_lo, ph_hi, coop, pad; };

__device__ __forceinline__ float bf2f(unsigned short b) { return __uint_as_float((unsigned)b << 16); }
__device__ __forceinline__ float bflo(unsigned w) { return __uint_as_float(w << 16); }
__device__ __forceinline__ float bfhi(unsigned w) { return __uint_as_float(w & 0xffff0000u); }
__device__ __forceinline__ unsigned pk2(float lo, float hi) { return pg8::cvt_pk_bf16(lo, hi); }
__device__ __forceinline__ float shx(float v, int o, int lane) { return __int_as_float(__builtin_amdgcn_ds_bpermute((lane ^ o) << 2, __float_as_int(v))); }
__device__ __forceinline__ float wave_sum(float v, int lane) {
#pragma unroll
    for (int o = 1; o < 64; o <<= 1) v += shx(v, o, lane);
    return v;
}
__device__ __forceinline__ float sigmoidf_(float x) { return __builtin_amdgcn_rcpf(1.f + __expf(-x)); }
__device__ __forceinline__ float siluf_(float x) { return x * sigmoidf_(x); }
__device__ __forceinline__ float logsig(float x) { return fminf(x, 0.f) - __logf(1.f + __expf(-fabsf(x))); }
__device__ __forceinline__ void tc_decode(int tc, int& m0, int& ms0, int& T) {
    if (tc < 64) { ms0 = (tc >> 2) * 256; T = 256; m0 = ms0 + (tc & 3) * 64; }
    else { const int s = tc - 64; ms0 = MPR + (s >> 6) * 4096; T = 4096; m0 = ms0 + (s & 63) * 64; }
}

namespace pg8 {
struct EpiSwiglu {
    static constexpr bool PERM = true, AFTER_DRAIN = false;
    bf16_t* U;
    __device__ __forceinline__ void operator()(const f32x4 (&acc)[2][2][4][2], const Unit& u, int wr, int wc, int fr, int fq) const {
        const int row0 = u.pm * BM + wr * 64 + fr, col0 = u.pn * 128 + wc * 32 + 8 * fq;
#pragma unroll
        for (int ai = 0; ai < 2; ++ai)
#pragma unroll
            for (int m = 0; m < 4; ++m) {
                bf16_t* p = U + (size_t)(row0 + ai * HALF + m * 16) * DFF + col0;
                const f32x4 a0 = acc[ai][0][m][0], a1 = acc[ai][0][m][1], b0 = acc[ai][1][m][0], b1 = acc[ai][1][m][1];
                float r[8];
#pragma unroll
                for (int e = 0; e < 4; ++e) { r[e] = siluf_(a0[e]) * b0[e]; r[4 + e] = siluf_(a1[e]) * b1[e]; }
                u32x4 w; w.x = cvt_pk_bf16(r[0], r[1]); w.y = cvt_pk_bf16(r[2], r[3]); w.z = cvt_pk_bf16(r[4], r[5]); w.w = cvt_pk_bf16(r[6], r[7]);
                *(u32x4*)p = w;
            }
    }
};
struct EpiResid {
    static constexpr bool PERM = true, AFTER_DRAIN = false;
    bf16_t* V; const float* stats; const float* lg; const float* lb; const float* mod; float gs; float* part;
    __device__ __forceinline__ void operator()(const f32x4 (&acc)[2][2][4][2], const Unit& u, int wr, int wc, int fr, int fq) const {
        const int mrow = (u.pm < 16) ? 0 : 1 + ((u.pm - 16) >> 4);
        const float* g = mod + (size_t)mrow * 9216;
        const int col0 = u.pn * BM + wc * 32 + 8 * fq, row0 = u.pm * BM + wr * 64 + fr;
        if (u.split >= 0) {
            float* ps = part + (size_t)u.split * PART_SLICE;
#pragma unroll
            for (int bj = 0; bj < 2; ++bj)
#pragma unroll
                for (int ai = 0; ai < 2; ++ai)
#pragma unroll
                    for (int m = 0; m < 4; ++m) { float* p = ps + (size_t)(row0 + ai * HALF + m * 16) * D + col0 + bj * HALF; *(f32x4*)p = acc[ai][bj][m][0]; *(f32x4*)(p + 4) = acc[ai][bj][m][1]; }
            return;
        }
#pragma unroll
        for (int bj = 0; bj < 2; ++bj) {
            const int col = col0 + bj * HALF;
            const f32x4 gv0 = *(const f32x4*)(g + col) * gs, gv1 = *(const f32x4*)(g + col + 4) * gs;
            const f32x4 lg0 = *(const f32x4*)(lg + col), lg1 = *(const f32x4*)(lg + col + 4), lb0 = *(const f32x4*)(lb + col), lb1 = *(const f32x4*)(lb + col + 4);
#pragma unroll
            for (int ai = 0; ai < 2; ++ai)
#pragma unroll
                for (int m = 0; m < 4; ++m) {
                    const int row = row0 + ai * HALF + m * 16;
                    bf16_t* p = V + (size_t)row * D + col;
                    const u32x4 w = *(const u32x4*)p; const f32x2 st = *(const f32x2*)(stats + 2 * row);
                    f32x4 x0 = (f32x4){bflo(w.x), bfhi(w.x), bflo(w.y), bfhi(w.y)}, x1 = (f32x4){bflo(w.z), bfhi(w.z), bflo(w.w), bfhi(w.w)};
                    x0 = (x0 - st.x) * st.y * lg0 + lb0; x1 = (x1 - st.x) * st.y * lg1 + lb1;
                    const f32x4 n0 = x0 * ALPHA + gv0 * acc[ai][bj][m][0], n1 = x1 * ALPHA + gv1 * acc[ai][bj][m][1];
                    u32x4 o; o.x = cvt_pk_bf16(n0[0], n0[1]); o.y = cvt_pk_bf16(n0[2], n0[3]); o.z = cvt_pk_bf16(n1[0], n1[1]); o.w = cvt_pk_bf16(n1[2], n1[3]);
                    *(u32x4*)p = o;
                }
        }
    }
};
struct EpiWin {
    static constexpr bool PERM = true, AFTER_DRAIN = false;
    bf16_t* Z; float* LR; float* outk; float* outv;
    __device__ __forceinline__ void operator()(const f32x4 (&acc)[2][2][4][2], const Unit& u, int wr, int wc, int fr, int fq) const {
        const int pn = u.pn, row0 = u.pm * BM + wr * 64 + fr, lane = fq * 16 + fr;
        const bool sample = u.pm >= 16;
        if (pn == 12) {
            if (wc == 0) {
#pragma unroll
                for (int ai = 0; ai < 2; ++ai)
#pragma unroll
                    for (int m = 0; m < 4; ++m)
#pragma unroll
                        for (int n = 0; n < 2; ++n) *(f32x4*)(LR + (size_t)(row0 + ai * HALF + m * 16) * 32 + 8 * fq + 4 * n) = acc[ai][0][m][n];
            }
            return;
        }
        const float scale = (pn == 2) ? 0.125f : ((pn == 6 || pn == 7) ? 0.125f * 1.4426950408889634f : 1.f);
        const bool rope = sample && pn >= 6 && pn <= 9;
        const bool ctxout = (!sample) && pn >= 8;
        float invf[2][4];
#pragma unroll
        for (int n = 0; n < 2; ++n)
#pragma unroll
            for (int e = 0; e < 4; ++e) invf[n][e] = __builtin_amdgcn_exp2f(-(float)(8 * (fq & 1) + 4 * n + e) * 0.83048202372184059f);
        const float sgn = (fq & 2) ? 1.f : -1.f;
#pragma unroll
        for (int ai = 0; ai < 2; ++ai)
#pragma unroll
            for (int m = 0; m < 4; ++m) {
                const int row = row0 + ai * HALF + m * 16;
                f32x4 v[2][2];
#pragma unroll
                for (int bj = 0; bj < 2; ++bj)
#pragma unroll
                    for (int n = 0; n < 2; ++n) v[bj][n] = acc[ai][bj][m][n];
                if (ctxout) {
                    float* ob = (pn < 10) ? outk : outv;
                    const int b = row >> 8, t = row & 255;
#pragma unroll
                    for (int bj = 0; bj < 2; ++bj) {
                        const int kcol = (pn & 1) * 256 + 128 * bj + 32 * wc + 8 * fq, hh = kcol >> 7, j = kcol & 127;
                        float* op = ob + ((size_t)((b * 8 + hh) * 256 + t)) * 128 + j;
                        *(f32x4*)op = v[bj][0]; *(f32x4*)(op + 4) = v[bj][1];
                    }
                }
                if (rope) {
                    const int t = (row - MPR) & 4095;
                    const float pos = (float)((wc & 1) ? (t & 63) : (t >> 6));
#pragma unroll
                    for (int n = 0; n < 2; ++n)
#pragma unroll
                        for (int e = 0; e < 4; ++e) {
                            const float ang = pos * invf[n][e], cs = __cosf(ang), sn = __sinf(ang) * sgn;
#pragma unroll
                            for (int bj = 0; bj < 2; ++bj) { const float x = v[bj][n][e], xp = shx(x, 32, lane); v[bj][n][e] = x * cs + xp * sn; }
                        }
                }
#pragma unroll
                for (int bj = 0; bj < 2; ++bj) {
                    bf16_t* p = Z + (size_t)row * NZ + pn * 256 + 128 * bj + 32 * wc + 8 * fq;
                    const f32x4 x0 = v[bj][0] * scale, x1 = v[bj][1] * scale;
                    u32x4 w; w.x = cvt_pk_bf16(x0[0], x0[1]); w.y = cvt_pk_bf16(x0[2], x0[3]); w.z = cvt_pk_bf16(x1[0], x1[1]); w.w = cvt_pk_bf16(x1[2], x1[3]);
                    *(u32x4*)p = w;
                }
            }
    }
};
struct EpiAny {
    static constexpr bool AFTER_DRAIN = false;
    const Args& a; int kind, l, gi; float gs; int lnidx;
    __device__ __forceinline__ bool perm() const { return true; }
    __device__ __forceinline__ void operator()(const f32x4 (&acc)[2][2][4][2], const Unit& u, int wr, int wc, int fr, int fq) const {
        if (kind == 3) {
#pragma unroll
            for (int ai = 0; ai < 2; ++ai)
#pragma unroll
                for (int bj = 0; bj < 2; ++bj)
#pragma unroll
                    for (int m = 0; m < 4; ++m)
#pragma unroll
                        for (int n = 0; n < 2; ++n) asm volatile("" :: "v"(acc[ai][bj][m][n]));
            return;
        }
        if (kind == 0) { EpiSwiglu e{(bf16_t*)(a.ws + WS_UZ)}; e(acc, u, wr, wc, fr, fq); }
        else if (kind == 1) { const float* ones = (const float*)(a.ws + WS_ONES); EpiResid e{(bf16_t*)(a.ws + WS_V), (const float*)(a.ws + WS_STATS), lnidx < 0 ? ones : a.in[24] + lnidx * D, lnidx < 0 ? ones + D : a.in[25] + lnidx * D, (const float*)(a.ws + WS_MOD) + (size_t)l * 9 * 9216 + gi * 1024, gs, (float*)(a.ws + WS_PART)}; e(acc, u, wr, wc, fr, fq); }
        else { EpiWin e{(bf16_t*)(a.ws + WS_UZ), (float*)(a.ws + WS_LR), a.out + OUT_K + (size_t)l * 4 * 256 * 128, a.out + OUT_V + (size_t)l * 4 * 256 * 128}; e(acc, u, wr, wc, fr, fq); }
    }
};
}

__device__ __forceinline__ void transpose_item(const float* W, int K, int N, bf16* WT, int k0, int n0, int drow0, float* scr, int lane) {
#pragma unroll 8
    for (int i = 0; i < 32; ++i) { const int kk = 2 * i + (lane >> 5); scr[kk * 33 + (lane & 31)] = W[(size_t)(k0 + kk) * N + n0 + (lane & 31)]; }
    asm volatile("s_waitcnt lgkmcnt(0)" ::: "memory");
    const int c = lane & 7;
#pragma unroll
    for (int j = 0; j < 4; ++j) {
        const int n = (lane >> 3) + 8 * j; const float* s = scr + (8 * c) * 33 + n;
        v4u o; o.x = pk2(s[0 * 33], s[1 * 33]); o.y = pk2(s[2 * 33], s[3 * 33]); o.z = pk2(s[4 * 33], s[5 * 33]); o.w = pk2(s[6 * 33], s[7 * 33]);
        *(v4u*)(WT + (size_t)(drow0 + n) * K + k0 + 8 * c) = o;
    }
    asm volatile("s_waitcnt lgkmcnt(0)" ::: "memory");
}

__device__ __forceinline__ void phase_prologue(const Args& a, unsigned char* lds, int tid, int lane, int wave) {
    OPQ_IDS();
    float* scr = (float*)lds + wave * 4096;
    const int gw = BID * 8 + wave, NGW = NB * 8;
    const int gt = BID * 512 + tid, NGT = NB * 512;
    constexpr int PER_L = 10512;
    for (int it = gw; it < 2 * PER_L; it += NGW) {
        const int l = it / PER_L; int r = it % PER_L;
        bf16* wl = (bf16*)(a.ws + WS_W) + (size_t)l * WL_ELEMS;
        if (r < 2816) { const int kb = r / 176, n0 = (r % 176) * 32, j = n0 < DFF ? n0 : n0 - DFF, dr = 256 * (j / 128) + (j % 128) + (n0 < DFF ? 0 : 128);
            transpose_item(a.in[9] + (size_t)l * 1024 * 5632, 1024, 5632, wl + W1I, kb * 64, n0, dr, scr, lane); continue; } r -= 2816;
        if (r < 1408) { const int kb = r / 32, n0 = (r % 32) * 32; transpose_item(a.in[10] + (size_t)l * DFF * 1024, DFF, 1024, wl + W1O, kb * 64, n0, n0, scr, lane); continue; } r -= 1408;
        if (r < 2816) { const int kb = r / 176, n0 = (r % 176) * 32, j = n0 < DFF ? n0 : n0 - DFF, dr = 256 * (j / 128) + (j % 128) + (n0 < DFF ? 0 : 128);
            transpose_item(a.in[11] + (size_t)l * 1024 * 5632, 1024, 5632, wl + W2I, kb * 64, n0, dr, scr, lane); continue; } r -= 2816;
        if (r < 1408) { const int kb = r / 32, n0 = (r % 32) * 32; transpose_item(a.in[12] + (size_t)l * DFF * 1024, DFF, 1024, wl + W2O, kb * 64, n0, n0, scr, lane); continue; } r -= 1408;
        if (r < 1552) { const int kb = r / 97, n0 = (r % 97) * 32, dr = n0 < 1536 ? n0 : (n0 < 1568 ? 3072 : n0 - 32);
            transpose_item(a.in[13] + (size_t)l * 1024 * 3104, 1024, 3104, wl + WIN, kb * 64, n0, dr, scr, lane); continue; } r -= 1552;
        { const int kb = r / 32, n0 = (r % 32) * 32; transpose_item(a.in[23] + (size_t)l * 1024 * 1024, 1024, 1024, wl + WOUT, kb * 64, n0, n0, scr, lane); }
    }
    for (int i = gt; i < 2048; i += NGT) ((float*)(a.ws + WS_ONES))[i] = i < 1024 ? 1.f : 0.f;
    for (int i = gt; i < 2 * 28672; i += NGT) { const int l = i / 28672, c = i % 28672;
        *(v4u*)((bf16*)(a.ws + WS_W) + (size_t)l * WL_ELEMS + WIN + (size_t)3104 * 1024 + (size_t)c * 8) = (v4u){0u, 0u, 0u, 0u}; }
    for (int i = gt; i < 2 * 524288; i += NGT) { const int which = i / 524288, c = i % 524288;
        const float* src = (which ? a.in[3] : a.in[2]) + (size_t)c * 8; const f32x4 x0 = *(const f32x4*)src, x1 = *(const f32x4*)(src + 4);
        v4u o; o.x = pk2(x0[0], x0[1]); o.y = pk2(x0[2], x0[3]); o.z = pk2(x1[0], x1[1]); o.w = pk2(x1[2], x1[3]);
        *(v4u*)((bf16*)(a.ws + (which ? WS_CV : WS_CK)) + (size_t)c * 8) = o; }
    __syncthreads();
    float* S = (float*)lds; float* red = (float*)lds + 9 * 1024;
    for (int i = tid; i < 9 * 1024; i += 512) { const int r = i >> 10, k = i & 1023; const float cv = r == 0 ? a.in[6][k] : a.in[5][(r - 1) * 1024 + k]; S[i] = siluf_(cv); }
    __syncthreads();
    float* MOD = (float*)(a.ws + WS_MOD);
    for (int item = BID; item < 288; item += NB) {
        const int l = item / 144, cb = item % 144;
        const float* wp = a.in[7] + (size_t)l * 1024 * 9216 + cb * 64 + lane;
        float acc[9];
#pragma unroll
        for (int r = 0; r < 9; ++r) acc[r] = 0.f;
#pragma unroll 8
        for (int kk = 0; kk < 128; ++kk) { const int k = wave * 128 + kk; const float wv = wp[(size_t)k * 9216];
#pragma unroll
            for (int r = 0; r < 9; ++r) acc[r] += S[r * 1024 + k] * wv; }
#pragma unroll
        for (int r = 0; r < 9; ++r) red[(wave * 9 + r) * 64 + lane] = acc[r];
        __syncthreads();
        for (int i = tid; i < 576; i += 512) { const int r = i >> 6, c = i & 63; float s = 0.f;
#pragma unroll
            for (int w = 0; w < 8; ++w) s += red[(w * 9 + r) * 64 + c];
            MOD[(size_t)(l * 9 + r) * 9216 + cb * 64 + c] = s + a.in[8][l * 9216 + cb * 64 + c]; }
        __syncthreads();
    }
}

__device__ __forceinline__ void phase_rowpass(const Args& a, int mode, int ln_idx, int mod_l, int mod_sub, int lane, int wave, bool dummy = false, int ps_n = 0, int ps_lnprev = -1, int ps_l = 0, int ps_gi = 0, float ps_gs = 0.f) {
    OPQ_IDS();
    const int gw = BID * 8 + wave, NGW = NB * 8;
    bf16* H = (bf16*)(a.ws + (dummy ? WS_UZ : WS_H));
    const bf16* V = (const bf16*)(a.ws + WS_V);
    float* STATS = (float*)(a.ws + WS_STATS);
    const float* MOD = (const float*)(a.ws + WS_MOD);
    for (int m = gw; m < M; m += NGW) {
        f32x4 v[4];
        if (mode == 0) {
            const float* src = m < MPR ? a.in[0] + (size_t)m * D : a.in[1] + (size_t)(m - MPR) * D;
#pragma unroll
            for (int j = 0; j < 2; ++j) { v[2 * j] = *((const f32x4*)src + (64 * j + lane) * 2); v[2 * j + 1] = *((const f32x4*)src + (64 * j + lane) * 2 + 1); }
#pragma unroll
            for (int j = 0; j < 2; ++j) *((v4u*)((bf16*)(a.ws + WS_V) + (size_t)m * D) + 64 * j + lane) = (v4u){pk2(v[2 * j][0], v[2 * j][1]), pk2(v[2 * j][2], v[2 * j][3]), pk2(v[2 * j + 1][0], v[2 * j + 1][1]), pk2(v[2 * j + 1][2], v[2 * j + 1][3])};
            if (lane == 0) { float z_, o_; asm volatile("v_mov_b32 %0, 0\n\tv_mov_b32 %1, 1.0" : "=v"(z_), "=v"(o_)); STATS[2 * m] = z_; STATS[2 * m + 1] = o_; }
        } else {
#pragma unroll
            for (int j = 0; j < 2; ++j) { const v4u w = *((const v4u*)(V + (size_t)m * D) + 64 * j + lane);
                v[2 * j] = (f32x4){bflo(w.x), bfhi(w.x), bflo(w.y), bfhi(w.y)}; v[2 * j + 1] = (f32x4){bflo(w.z), bfhi(w.z), bflo(w.w), bfhi(w.w)}; }
            if (ps_n > 0 && m < MPR) {
                const float* ones = (const float*)(a.ws + WS_ONES);
                const float* lgp = ps_lnprev < 0 ? ones : a.in[24] + ps_lnprev * D; const float* lbp = ps_lnprev < 0 ? ones + D : a.in[25] + ps_lnprev * D;
                const float mo = STATS[2 * m], ro = STATS[2 * m + 1];
                const float* gp = MOD + (size_t)(ps_l * 9) * 9216 + ps_gi * 1024;
                const float* pp = (const float*)(a.ws + WS_PART) + (size_t)m * D;
#pragma unroll
                for (int j = 0; j < 2; ++j)
#pragma unroll
                    for (int q = 0; q < 2; ++q) {
                        const int c4 = (64 * j + lane) * 2 + q;
                        f32x4 ps = *((const f32x4*)pp + c4);
                        for (int s = 1; s < ps_n; ++s) ps += *((const f32x4*)(pp + (size_t)s * PART_SLICE) + c4);
                        const f32x4 x = (v[2 * j + q] - mo) * ro * *((const f32x4*)lgp + c4) + *((const f32x4*)lbp + c4);
                        v[2 * j + q] = x * ALPHA + *((const f32x4*)gp + c4) * ps_gs * ps;
                    }
#pragma unroll
                for (int j = 0; j < 2; ++j) *((v4u*)((bf16*)(a.ws + WS_V) + (size_t)m * D) + 64 * j + lane) = (v4u){pk2(v[2 * j][0], v[2 * j][1]), pk2(v[2 * j][2], v[2 * j][3]), pk2(v[2 * j + 1][0], v[2 * j + 1][1]), pk2(v[2 * j + 1][2], v[2 * j + 1][3])};
            }
            float s = 0.f;
#pragma unroll
            for (int j = 0; j < 4; ++j) s += (v[j][0] + v[j][1]) + (v[j][2] + v[j][3]);
            const float mean = wave_sum(s, lane) * (1.f / D); float s2 = 0.f;
#pragma unroll
            for (int j = 0; j < 4; ++j) { v[j] = v[j] - mean; s2 += (v[j][0] * v[j][0] + v[j][1] * v[j][1]) + (v[j][2] * v[j][2] + v[j][3] * v[j][3]); }
            const float rstd = 1.f / sqrtf(wave_sum(s2, lane) * (1.f / D) + LN_EPS);
            if (mode == 1 && lane == 0 && !dummy) { STATS[2 * m] = mean; STATS[2 * m + 1] = rstd; }
            const float* g = a.in[24] + ln_idx * D; const float* bb = a.in[25] + ln_idx * D;
#pragma unroll
            for (int j = 0; j < 2; ++j)
#pragma unroll
                for (int q = 0; q < 2; ++q) { const f32x4 gv = *((const f32x4*)g + (64 * j + lane) * 2 + q), bv = *((const f32x4*)bb + (64 * j + lane) * 2 + q); v[2 * j + q] = v[2 * j + q] * rstd * gv + bv; }
        }
        if (mode == 2) {
            float* xo = a.out + (size_t)m * D;
#pragma unroll
            for (int j = 0; j < 2; ++j) { *((f32x4*)xo + (64 * j + lane) * 2) = v[2 * j]; *((f32x4*)xo + (64 * j + lane) * 2 + 1) = v[2 * j + 1]; }
        } else {
            const int mrow = m < MPR ? 0 : 1 + ((m - MPR) >> 12);
            const float* mp = MOD + (size_t)(mod_l * 9 + mrow) * 9216 + 3 * mod_sub * 1024;
#pragma unroll
            for (int j = 0; j < 2; ++j) {
                f32x4 h[2];
#pragma unroll
                for (int q = 0; q < 2; ++q) { const f32x4 sh = *((const f32x4*)mp + (64 * j + lane) * 2 + q), sc = *((const f32x4*)(mp + 1024) + (64 * j + lane) * 2 + q); h[q] = v[2 * j + q] * (sc + 1.f) + sh; }
                *((v4u*)(H + (size_t)m * D) + 64 * j + lane) = (v4u){pk2(h[0][0], h[0][1]), pk2(h[0][2], h[0][3]), pk2(h[1][0], h[1][1]), pk2(h[1][2], h[1][3])};
            }
        }
    }
}

__device__ __forceinline__ void conv_item(const Args& a, unsigned char* lds, int l, int tc, int tid, int lane, int wave) {
    int m0, ms0, T; tc_decode(tc, m0, ms0, T);
    const bf16* Z = (const bf16*)(a.ws + WS_UZ);
    bf16* Y = (bf16*)(a.ws + WS_H);
    float* Yl = (float*)lds;
    for (int ch = tid; ch < 94 * 32; ch += 512) {
        const int rr = ch >> 5, c8 = (ch & 31) * 8, mt = m0 - 15 + rr;
        f32x4 y0 = {0.f, 0.f, 0.f, 0.f}, y1 = y0;
        if (mt >= ms0 && mt < ms0 + T) {
            const v4u av = *(const v4u*)(Z + (size_t)mt * NZ + c8), gv = *(const v4u*)(Z + (size_t)mt * NZ + 256 + c8);
            y0[0] = bflo(av.x) * sigmoidf_(bflo(gv.x)); y0[1] = bfhi(av.x) * sigmoidf_(bfhi(gv.x));
            y0[2] = bflo(av.y) * sigmoidf_(bflo(gv.y)); y0[3] = bfhi(av.y) * sigmoidf_(bfhi(gv.y));
            y1[0] = bflo(av.z) * sigmoidf_(bflo(gv.z)); y1[1] = bfhi(av.z) * sigmoidf_(bfhi(gv.z));
            y1[2] = bflo(av.w) * sigmoidf_(bflo(gv.w)); y1[3] = bfhi(av.w) * sigmoidf_(bfhi(gv.w));
        }
        *(f32x4*)(Yl + rr * 256 + c8) = y0; *(f32x4*)(Yl + rr * 256 + c8 + 4) = y1;
    }
    __syncthreads();
    {
        const int c = tid & 255, half = tid >> 8;
        float w[31];
#pragma unroll
        for (int j = 0; j < 31; ++j) w[j] = a.in[14][(size_t)(l * 31 + j) * 256 + c];
        const float bias = a.in[15][l * 256 + c];
        for (int tt = 0; tt < 32; ++tt) {
            const int tl = half * 32 + tt; float acc = bias;
#pragma unroll
            for (int j = 0; j < 31; ++j) acc += w[j] * Yl[(tl + j) * 256 + c];
            Yl[(half ? 94 + tt : tl) * 256 + c] = acc;
        }
    }
    __syncthreads();
    {
        const f32x4 g = *((const f32x4*)(a.in[16] + l * 256) + lane), bb = *((const f32x4*)(a.in[17] + l * 256) + lane);
#pragma unroll
        for (int q = 0; q < 8; ++q) {
            const int tl = wave * 8 + q, rix = tl < 32 ? tl : 94 + (tl - 32);
            f32x4 x = *((const f32x4*)(Yl + rix * 256) + lane);
            const float mean = wave_sum((x[0] + x[1]) + (x[2] + x[3]), lane) * (1.f / 256.f);
            x = x - mean;
            const float rstd = 1.f / sqrtf(wave_sum((x[0] * x[0] + x[1] * x[1]) + (x[2] * x[2] + x[3] * x[3]), lane) * (1.f / 256.f) + LN_EPS);
            x = x * rstd * g + bb;
            v2u wv; wv.x = pk2(siluf_(x[0]), siluf_(x[1])); wv.y = pk2(siluf_(x[2]), siluf_(x[3]));
            *((v2u*)(Y + (size_t)(m0 + tl) * D) + lane) = wv;
        }
    }
    __syncthreads();
}

template <int NG>
__device__ __forceinline__ void gla_cumsum_pre(const float (&wa)[16], float ba, int d, int grp, int dk, const float* lrS, float* G) {
    constexpr int TG = 64 / NG;
    {
        float run = 0.f;
#pragma unroll 4
        for (int ii = 0; ii < TG; ++ii) {
            const int i = grp * TG + (d == 0 ? ii : TG - 1 - ii);
            float x = ba;
#pragma unroll
            for (int r = 0; r < 16; ++r) x += lrS[i * 32 + 16 * d + r] * wa[r];
            run += logsig(x) * (1.f / 16.f);
            G[i * 68 + dk] = run;
        }
    }
    __syncthreads();
    float off = 0.f;
    if (d == 0) { for (int g = 0; g < grp; ++g) off += G[(g * TG + TG - 1) * 68 + dk]; }
    else { for (int g = grp + 1; g < NG; ++g) off += G[(g * TG) * 68 + dk]; }
    __syncthreads();
#pragma unroll 4
    for (int ii = 0; ii < TG; ++ii) G[(grp * TG + ii) * 68 + dk] += off;
    __syncthreads();
}
template <int NG>
__device__ __forceinline__ void gla_cumsum(const Args& a, int l, int h, int d, int grp, bool active, int dk, const float* lrS, float* G) {
    constexpr int TG = 64 / NG;
    if (active) {
        float wa[16];
#pragma unroll
        for (int r = 0; r < 16; ++r) wa[r] = a.in[18][(size_t)((l * 2 + d) * 16 + r) * 256 + h * 64 + dk];
        const float ba = a.in[19][(l * 2 + d) * 256 + h * 64 + dk];
        float run = 0.f;
#pragma unroll 4
        for (int ii = 0; ii < TG; ++ii) {
            const int i = grp * TG + (d == 0 ? ii : TG - 1 - ii);
            float x = ba;
#pragma unroll
            for (int r = 0; r < 16; ++r) x += lrS[i * 32 + 16 * d + r] * wa[r];
            run += logsig(x) * (1.f / 16.f);
            G[i * 68 + dk] = run;
        }
    }
    __syncthreads();
    float off = 0.f;
    if (active) {
        if (d == 0) { for (int g = 0; g < grp; ++g) off += G[(g * TG + TG - 1) * 68 + dk]; }
        else { for (int g = grp + 1; g < NG; ++g) off += G[(g * TG) * 68 + dk]; }
    }
    __syncthreads();
    if (active) {
#pragma unroll 4
        for (int ii = 0; ii < TG; ++ii) G[(grp * TG + ii) * 68 + dk] += off;
    }
    __syncthreads();
}

#if !GLA_MFMA
__device__ __forceinline__ void gla_g1_item(const Args& a, unsigned char* lds, int l, int item, int tid) {
    const int tc = item >> 2, h = item & 3;
    int m0, ms0, T; tc_decode(tc, m0, ms0, T);
    const bf16* Z = (const bf16*)(a.ws + WS_UZ);
    const float* LR = (const float*)(a.ws + WS_LR);
    float* KVS = a.out; float* DEC = (float*)(a.ws + WS_DEC);
    float* lrS = (float*)lds; float* Gf = lrS + 2048; float* Gb = Gf + 4352; float* kS = Gb + 4352; float* vS = kS + 4352; float* KH = vS + 4352;
    *((f32x4*)lrS + tid) = *((const f32x4*)(LR + (size_t)m0 * 32) + tid);
    {
        const int i = tid >> 3, c8 = (tid & 7) * 8;
        const v4u kv = *(const v4u*)(Z + (size_t)(m0 + i) * NZ + ZC_GK + h * 64 + c8), vv = *(const v4u*)(Z + (size_t)(m0 + i) * NZ + ZC_GV + h * 64 + c8);
        float* kp = kS + i * 68 + c8; float* vp = vS + i * 68 + c8;
        *(f32x4*)kp = (f32x4){bflo(kv.x), bfhi(kv.x), bflo(kv.y), bfhi(kv.y)}; *(f32x4*)(kp + 4) = (f32x4){bflo(kv.z), bfhi(kv.z), bflo(kv.w), bfhi(kv.w)};
        *(f32x4*)vp = (f32x4){bflo(vv.x), bfhi(vv.x), bflo(vv.y), bfhi(vv.y)}; *(f32x4*)(vp + 4) = (f32x4){bflo(vv.z), bfhi(vv.z), bflo(vv.w), bfhi(vv.w)};
    }
    __syncthreads();
    {
        const int w = tid >> 6, d = w >> 2;
        gla_cumsum<4>(a, l, h, d, w & 3, true, tid & 63, lrS, d == 0 ? Gf : Gb);
    }
    for (int e = tid; e < 8192; e += 512) {
        const int d = e >> 12, i = (e >> 6) & 63, dk = e & 63;
        const float* G = d == 0 ? Gf : Gb; const float glast = d == 0 ? Gf[63 * 68 + dk] : Gb[dk];
        KH[d * 4352 + i * 68 + dk] = kS[i * 68 + dk] * __expf(glast - G[i * 68 + dk]);
    }
    if (tid < 128) { const int d = tid >> 6, dk = tid & 63; const float glast = d == 0 ? Gf[63 * 68 + dk] : Gb[dk];
        DEC[(size_t)((tc * 4 + h) * 2 + d) * 64 + dk] = __expf(glast); }
    __syncthreads();
    {
        const int d = tid >> 8, t2 = tid & 255, dk0 = (t2 >> 4) * 4, dv0 = (t2 & 15) * 4;
        const float* kh = KH + d * 4352;
        f32x4 acc[4];
#pragma unroll
        for (int x = 0; x < 4; ++x) acc[x] = (f32x4){0.f, 0.f, 0.f, 0.f};
#pragma unroll 4
        for (int s = 0; s < 64; ++s) { const f32x4 ka = *(const f32x4*)(kh + s * 68 + dk0), vb = *(const f32x4*)(vS + s * 68 + dv0);
#pragma unroll
            for (int x = 0; x < 4; ++x) acc[x] += ka[x] * vb; }
        float* o = KVS + (size_t)((tc * 4 + h) * 2 + d) * 4096;
#pragma unroll
        for (int x = 0; x < 4; ++x) *(f32x4*)(o + (dk0 + x) * 64 + dv0) = acc[x];
    }
    __syncthreads();
}

#endif
__device__ __forceinline__ void gla_scan(const Args& a, int l, int tid, size_t woff = 0) {
    OPQ_IDS();
    float* KVS = a.out; const float* DEC = (const float*)(a.ws + WS_DEC);
    const int gt = BID * 512 + tid, NGT = NB * 512;
    for (int task = gt; task < 65536; task += NGT) {
        const int e = (task & 1023) * 4, d = (task >> 10) & 1, h = (task >> 11) & 3, b = task >> 13;
        const int pdk = 16 * (e >> 10) + 4 * ((e >> 6) & 3), pdv = 16 * ((e >> 8) & 3) + ((e >> 2) & 15);
        const float* s0 = a.in[4] + (size_t)(((b * 2 + l) * 2 + d) * 4 + h) * 4096 + pdk * 64 + pdv;
        f32x4 S = {s0[0], s0[64], s0[128], s0[192]};
        const int base = 64 + b * 64;
        for (int n0 = 0; n0 < 64; n0 += 8) {
            f32x4 kvv[8], dd[8]; float* p[8];
#pragma unroll
            for (int u = 0; u < 8; ++u) { const int n = n0 + u, tc = d == 0 ? base + n : base + 63 - n; const size_t idx = (size_t)((tc * 4 + h) * 2 + d);
                p[u] = KVS + idx * 4096 + e; kvv[u] = *(const f32x4*)p[u]; dd[u] = *(const f32x4*)(DEC + idx * 64 + pdk); }
#pragma unroll
            for (int u = 0; u < 8; ++u) { *(f32x4*)(p[u] + woff) = S; S = dd[u] * S + kvv[u]; }
        }
    }
    for (int task = gt; task < 131072; task += NGT) {
        const int e = (task & 1023) * 4, d = (task >> 10) & 1, h = (task >> 11) & 3, b = task >> 13;
        const int pdk = 16 * (e >> 10) + 4 * ((e >> 6) & 3), pdv = 16 * ((e >> 8) & 3) + ((e >> 2) & 15);
        f32x4 S = {0.f, 0.f, 0.f, 0.f}; const int base = b * 4;
        f32x4 kvv[4], dd[4]; float* p[4];
#pragma unroll
        for (int u = 0; u < 4; ++u) { const int tc = d == 0 ? base + u : base + 3 - u; const size_t idx = (size_t)((tc * 4 + h) * 2 + d);
            p[u] = KVS + idx * 4096 + e; kvv[u] = *(const f32x4*)p[u]; dd[u] = *(const f32x4*)(DEC + idx * 64 + pdk); }
#pragma unroll
        for (int u = 0; u < 4; ++u) { *(f32x4*)(p[u] + woff) = S; S = dd[u] * S + kvv[u]; }
        if (woff == 0) { float* o = a.out + OUT_G + (size_t)(((b * 2 + l) * 2 + d) * 4 + h) * 4096 + pdk * 64 + pdv; o[0] = S[0]; o[64] = S[1]; o[128] = S[2]; o[192] = S[3]; }
    }
}

#if !GLA_MFMA
__device__ __forceinline__ void gla_g3_item(const Args& a, unsigned char* lds, int l, int item, int tid) {
    const int tc = item >> 2, h = item & 3;
    int m0, ms0, T; tc_decode(tc, m0, ms0, T);
    const bf16* Z = (const bf16*)(a.ws + WS_UZ);
    const float* LR = (const float*)(a.ws + WS_LR);
    const float* KVS = a.out;
    bf16* Y = (bf16*)(a.ws + WS_H);
    float* lrS = (float*)lds; float* vS = lrS + 2048; float* GA = vS + 4352; float* QT = GA + 4352; float* KT = QT + 4352; float* SS = KT + 4352;
    *((f32x4*)lrS + tid) = *((const f32x4*)(LR + (size_t)m0 * 32) + tid);
    {
        const int i = tid >> 3, c8 = (tid & 7) * 8;
        const v4u vv = *(const v4u*)(Z + (size_t)(m0 + i) * NZ + ZC_GV + h * 64 + c8);
        float* vp = vS + i * 68 + c8;
        *(f32x4*)vp = (f32x4){bflo(vv.x), bfhi(vv.x), bflo(vv.y), bfhi(vv.y)}; *(f32x4*)(vp + 4) = (f32x4){bflo(vv.z), bfhi(vv.z), bflo(vv.w), bfhi(vv.w)};
    }
    __syncthreads();
    const int ib = tid >> 4, jb = tid & 15, dv0 = jb * 4;
    f32x4 o[2];
    o[0] = (f32x4){0.f, 0.f, 0.f, 0.f}; o[1] = o[0];
    for (int d = 0; d < 2; ++d) {
        gla_cumsum<8>(a, l, h, d, tid >> 6, true, tid & 63, lrS, GA);
        {
            const int i = tid >> 3, c8 = (tid & 7) * 8;
            const v4u qv = *(const v4u*)(Z + (size_t)(m0 + i) * NZ + ZC_GQ + h * 64 + c8), kv = *(const v4u*)(Z + (size_t)(m0 + i) * NZ + ZC_GK + h * 64 + c8);
            const float qq[8] = {bflo(qv.x), bfhi(qv.x), bflo(qv.y), bfhi(qv.y), bflo(qv.z), bfhi(qv.z), bflo(qv.w), bfhi(qv.w)};
            const float kk[8] = {bflo(kv.x), bfhi(kv.x), bflo(kv.y), bfhi(kv.y), bflo(kv.z), bfhi(kv.z), bflo(kv.w), bfhi(kv.w)};
#pragma unroll
            for (int e = 0; e < 8; ++e) { const float g = GA[i * 68 + c8 + e]; QT[i * 68 + c8 + e] = qq[e] * __expf(g); KT[i * 68 + c8 + e] = kk[e] * __expf(-g); }
            const float* sp = KVS + (size_t)((tc * 4 + h) * 2 + d) * 4096;
#pragma unroll
            for (int x = 0; x < 2; ++x) { const int f = tid + 512 * x, dk = f >> 4, dv4 = (f & 15) * 4; *(f32x4*)(SS + dk * 68 + dv4) = *(const f32x4*)(sp + dk * 64 + dv4); }
        }
        __syncthreads();
        {
            float acc[2][4];
#pragma unroll
            for (int ii = 0; ii < 2; ++ii)
#pragma unroll
                for (int jj = 0; jj < 4; ++jj) acc[ii][jj] = 0.f;
#pragma unroll 4
            for (int k4 = 0; k4 < 16; ++k4) {
                f32x4 qa[2], kb[4];
#pragma unroll
                for (int ii = 0; ii < 2; ++ii) qa[ii] = *(const f32x4*)(QT + (ib + 32 * ii) * 68 + 4 * k4);
#pragma unroll
                for (int jj = 0; jj < 4; ++jj) kb[jj] = *(const f32x4*)(KT + (jb + 16 * jj) * 68 + 4 * k4);
#pragma unroll
                for (int ii = 0; ii < 2; ++ii)
#pragma unroll
                    for (int jj = 0; jj < 4; ++jj) acc[ii][jj] += (qa[ii][0] * kb[jj][0] + qa[ii][1] * kb[jj][1]) + (qa[ii][2] * kb[jj][2] + qa[ii][3] * kb[jj][3]);
            }
#pragma unroll
            for (int ii = 0; ii < 2; ++ii)
#pragma unroll
                for (int jj = 0; jj < 4; ++jj) { const int i = ib + 32 * ii, j = jb + 16 * jj; const bool keep = d == 0 ? (j <= i) : (j >= i); GA[i * 68 + j] = keep ? acc[ii][jj] : 0.f; }
        }
        __syncthreads();
        {
#pragma unroll 2
            for (int j4 = 0; j4 < 16; ++j4) {
                f32x4 av[2];
#pragma unroll
                for (int ii = 0; ii < 2; ++ii) av[ii] = *(const f32x4*)(GA + (ib + 32 * ii) * 68 + 4 * j4);
#pragma unroll
                for (int jj = 0; jj < 4; ++jj) { const f32x4 vv = *(const f32x4*)(vS + (4 * j4 + jj) * 68 + dv0); o[0] += av[0][jj] * vv; o[1] += av[1][jj] * vv; }
            }
#pragma unroll 2
            for (int k4 = 0; k4 < 16; ++k4) {
                f32x4 qv[2];
#pragma unroll
                for (int ii = 0; ii < 2; ++ii) qv[ii] = *(const f32x4*)(QT + (ib + 32 * ii) * 68 + 4 * k4);
#pragma unroll
                for (int x = 0; x < 4; ++x) { const f32x4 sv = *(const f32x4*)(SS + (4 * k4 + x) * 68 + dv0); o[0] += qv[0][x] * sv; o[1] += qv[1][x] * sv; }
            }
        }
        __syncthreads();
    }
    const f32x4 gn = *(const f32x4*)(a.in[20] + l * 64 + dv0);
#pragma unroll
    for (int ii = 0; ii < 2; ++ii) {
        const int i = ib + 32 * ii;
        float ss = (o[ii][0] * o[ii][0] + o[ii][1] * o[ii][1]) + (o[ii][2] * o[ii][2] + o[ii][3] * o[ii][3]);
        ss += shx(ss, 1, tid & 63); ss += shx(ss, 2, tid & 63); ss += shx(ss, 4, tid & 63); ss += shx(ss, 8, tid & 63);
        const float rstd = 1.f / sqrtf(ss * (1.f / 64.f) + LN_EPS);
        const v2u gw = *(const v2u*)(Z + (size_t)(m0 + i) * NZ + ZC_GG + h * 64 + dv0);
        const f32x4 y = o[ii] * rstd * gn;
        v2u w; w.x = pk2(y[0] * siluf_(bflo(gw.x)), y[1] * siluf_(bfhi(gw.x))); w.y = pk2(y[2] * siluf_(bflo(gw.y)), y[3] * siluf_(bfhi(gw.y)));
        *(v2u*)(Y + (size_t)(m0 + i) * D + 256 + h * 64 + dv0) = w;
    }
}

#else
__device__ __forceinline__ unsigned f2bf1(float f) { const unsigned u = __float_as_uint(f); return (u + 0x7fffu + ((u >> 16) & 1u)) >> 16; }
__device__ __forceinline__ f32x4 mfma16(bf16x8 a, bf16x8 b, f32x4 c) { return __builtin_amdgcn_mfma_f32_16x16x32_bf16(a, b, c, 0, 0, 0); }
__device__ __forceinline__ void gla_build_vt(const bf16* Z, int m0, int h, bf16* VT, int tid) {
    const int dv = tid & 63, jg = tid >> 6;
    const bf16* vp = Z + (size_t)(m0 + 8 * jg) * NZ + ZC_GV + h * 64 + dv;
    unsigned e[8];
#pragma unroll
    for (int x = 0; x < 8; ++x) e[x] = vp[(size_t)x * NZ];
    *(v4u*)(VT + dv * 72 + 8 * jg) = (v4u){e[0] | (e[1] << 16), e[2] | (e[3] << 16), e[4] | (e[5] << 16), e[6] | (e[7] << 16)};
}
__device__ __forceinline__ void gla_g1_item(const Args& a, unsigned char* lds, int l, int item, int tid) {
    const int tc = item >> 2, h = item & 3;
    int m0, ms0, T; tc_decode(tc, m0, ms0, T);
    const bf16* Z = (const bf16*)(a.ws + WS_UZ);
    const float* LR = (const float*)(a.ws + WS_LR);
    float* KVS = a.out; float* DEC = (float*)(a.ws + WS_DEC);
    float* lrS = (float*)lds; float* Gf = (float*)(lds + 8192); float* Gb = (float*)(lds + 25600);
    bf16* KHT = (bf16*)(lds + 43008); bf16* VT = (bf16*)(lds + 61440);
    const int lane = tid & 63, w = tid >> 6, l16 = lane & 15, lq = lane >> 4;
    unsigned kx[8];
    { const bf16* kp = Z + (size_t)(m0 + 8 * w) * NZ + ZC_GK + h * 64 + lane;
#pragma unroll
      for (int x = 0; x < 8; ++x) kx[x] = kp[(size_t)x * NZ]; }
    float wa[16];
    const int dcs = w >> 2;
#pragma unroll
    for (int r = 0; r < 16; ++r) wa[r] = a.in[18][(size_t)((l * 2 + dcs) * 16 + r) * 256 + h * 64 + lane];
    const float ba = a.in[19][(l * 2 + dcs) * 256 + h * 64 + lane];
    *((f32x4*)lrS + tid) = *((const f32x4*)(LR + (size_t)m0 * 32) + tid);
    gla_build_vt(Z, m0, h, VT, tid);
    __syncthreads();
    gla_cumsum_pre<4>(wa, ba, dcs, w & 3, lane, lrS, dcs == 0 ? Gf : Gb);
#pragma unroll
    for (int d = 0; d < 2; ++d) {
        const int dk = lane, sg = w;
        const float* G = d == 0 ? Gf : Gb; const float glast = d == 0 ? Gf[63 * 68 + dk] : Gb[dk];
        unsigned e[8];
#pragma unroll
        for (int x = 0; x < 8; ++x) e[x] = f2bf1(bf2f((unsigned short)kx[x]) * __expf(glast - G[(8 * sg + x) * 68 + dk]));
        *(v4u*)(KHT + d * 4608 + dk * 72 + 8 * sg) = (v4u){e[0] | (e[1] << 16), e[2] | (e[3] << 16), e[4] | (e[5] << 16), e[6] | (e[7] << 16)};
    }
    if (tid < 128) { const int d = tid >> 6, dk = tid & 63; const float glast = d == 0 ? Gf[63 * 68 + dk] : Gb[dk];
        DEC[(size_t)((tc * 4 + h) * 2 + d) * 64 + dk] = __expf(glast); }
    __syncthreads();
    {
        const int d = w >> 2, mt = w & 3;
        float* o = KVS + (size_t)((tc * 4 + h) * 2 + d) * 4096;
        bf16x8 af[2];
#pragma unroll
        for (int ks = 0; ks < 2; ++ks) af[ks] = *(const bf16x8*)(KHT + d * 4608 + (16 * mt + l16) * 72 + 32 * ks + 8 * lq);
#pragma unroll
        for (int nt = 0; nt < 4; ++nt) {
            f32x4 acc = {0.f, 0.f, 0.f, 0.f};
#pragma unroll
            for (int ks = 0; ks < 2; ++ks) acc = mfma16(af[ks], *(const bf16x8*)(VT + (16 * nt + l16) * 72 + 32 * ks + 8 * lq), acc);
            *(f32x4*)(o + ((mt * 4 + nt) * 64 + lane) * 4) = acc;
        }
    }
    __syncthreads();
}
__device__ __forceinline__ void gla_g3_item(const Args& a, unsigned char* lds, int l, int item, int tid) {
    const int tc = item >> 2, h = item & 3;
    int m0, ms0, T; tc_decode(tc, m0, ms0, T);
    const bf16* Z = (const bf16*)(a.ws + WS_UZ);
    const float* LR = (const float*)(a.ws + WS_LR);
    const float* KVS = a.out;
    bf16* Y = (bf16*)(a.ws + WS_H);
    const int lane = tid & 63, w = tid >> 6, l16 = lane & 15, lq = lane >> 4, d = w >> 2, mt = w & 3, td = tid & 255;
    float* lrS = (float*)lds; bf16* VT = (bf16*)(lds + 8192);
    unsigned char* db = lds + 17408 + d * 54272;
    float* GA = (float*)db; bf16* QT = (bf16*)(db + 17408); bf16* KT = (bf16*)(db + 26624); bf16* PB = (bf16*)(db + 35840); bf16* ST = (bf16*)(db + 45056);
    float* OX = (float*)(lds + 17408 + 54272);
    const int qi = td >> 2, c16 = (td & 3) * 16;
    v4u qv2[2], kv2[2];
    { const bf16* qp = Z + (size_t)(m0 + qi) * NZ + ZC_GQ + h * 64 + c16; const bf16* kp = Z + (size_t)(m0 + qi) * NZ + ZC_GK + h * 64 + c16;
      qv2[0] = *(const v4u*)qp; qv2[1] = *(const v4u*)(qp + 8); kv2[0] = *(const v4u*)kp; kv2[1] = *(const v4u*)(kp + 8); }
    const int sdv = td & 63, skg = td >> 6;
    f32x4 s4[4];
    { const float* sp = KVS + (size_t)((tc * 4 + h) * 2 + d) * 4096 + ((skg * 4 + (sdv >> 4)) * 64 + (sdv & 15)) * 4;
#pragma unroll
      for (int q4 = 0; q4 < 4; ++q4) s4[q4] = *(const f32x4*)(sp + q4 * 64); }
    float wa[16];
#pragma unroll
    for (int r = 0; r < 16; ++r) wa[r] = a.in[18][(size_t)((l * 2 + d) * 16 + r) * 256 + h * 64 + lane];
    const float ba = a.in[19][(l * 2 + d) * 256 + h * 64 + lane];
    unsigned gx[4][4];
    if (d == 0) {
#pragma unroll
        for (int j = 0; j < 4; ++j)
#pragma unroll
            for (int nt = 0; nt < 4; ++nt) gx[j][nt] = Z[(size_t)(m0 + 16 * mt + 4 * lq + j) * NZ + ZC_GG + h * 64 + 16 * nt + l16];
    }
    *((f32x4*)lrS + tid) = *((const f32x4*)(LR + (size_t)m0 * 32) + tid);
    gla_build_vt(Z, m0, h, VT, tid);
    __syncthreads();
    gla_cumsum_pre<4>(wa, ba, d, mt, lane, lrS, GA);
    {
        const int i = qi;
#pragma unroll
        for (int hf = 0; hf < 2; ++hf) {
            const v4u qv = qv2[hf], kv = kv2[hf];
            const float qq[8] = {bflo(qv.x), bfhi(qv.x), bflo(qv.y), bfhi(qv.y), bflo(qv.z), bfhi(qv.z), bflo(qv.w), bfhi(qv.w)};
            const float kk[8] = {bflo(kv.x), bfhi(kv.x), bflo(kv.y), bfhi(kv.y), bflo(kv.z), bfhi(kv.z), bflo(kv.w), bfhi(kv.w)};
            float qo[8], ko[8];
#pragma unroll
            for (int e = 0; e < 8; ++e) { const float g = GA[i * 68 + c16 + 8 * hf + e]; qo[e] = qq[e] * __expf(g); ko[e] = kk[e] * __expf(-g); }
            *(v4u*)(QT + i * 72 + c16 + 8 * hf) = (v4u){pk2(qo[0], qo[1]), pk2(qo[2], qo[3]), pk2(qo[4], qo[5]), pk2(qo[6], qo[7])};
            *(v4u*)(KT + i * 72 + c16 + 8 * hf) = (v4u){pk2(ko[0], ko[1]), pk2(ko[2], ko[3]), pk2(ko[4], ko[5]), pk2(ko[6], ko[7])};
        }
        *(v4u*)(ST + sdv * 72 + 16 * skg) = (v4u){pk2(s4[0][0], s4[0][1]), pk2(s4[0][2], s4[0][3]), pk2(s4[1][0], s4[1][1]), pk2(s4[1][2], s4[1][3])};
        *(v4u*)(ST + sdv * 72 + 16 * skg + 8) = (v4u){pk2(s4[2][0], s4[2][1]), pk2(s4[2][2], s4[2][3]), pk2(s4[3][0], s4[3][1]), pk2(s4[3][2], s4[3][3])};
    }
    __syncthreads();
    {
        bf16x8 af[2];
#pragma unroll
        for (int ks = 0; ks < 2; ++ks) af[ks] = *(const bf16x8*)(QT + (16 * mt + l16) * 72 + 32 * ks + 8 * lq);
#pragma unroll
        for (int nt = 0; nt < 4; ++nt) {
            f32x4 p = {0.f, 0.f, 0.f, 0.f};
#pragma unroll
            for (int ks = 0; ks < 2; ++ks) p = mfma16(af[ks], *(const bf16x8*)(KT + (16 * nt + l16) * 72 + 32 * ks + 8 * lq), p);
#pragma unroll
            for (int j = 0; j < 4; ++j) { const int i = 16 * mt + 4 * lq + j, jc = 16 * nt + l16; const bool keep = d == 0 ? (jc <= i) : (jc >= i);
                PB[i * 72 + jc] = (bf16)f2bf1(keep ? p[j] : 0.f); }
        }
    }
    __syncthreads();
    f32x4 acc[4];
#pragma unroll
    for (int nt = 0; nt < 4; ++nt) acc[nt] = (f32x4){0.f, 0.f, 0.f, 0.f};
    {
        bf16x8 afr[4], bfr[4][4];
#pragma unroll
        for (int ks = 0; ks < 4; ++ks) {
            afr[ks] = *(const bf16x8*)((ks < 2 ? PB : QT) + (16 * mt + l16) * 72 + 32 * (ks & 1) + 8 * lq);
#pragma unroll
            for (int nt = 0; nt < 4; ++nt) bfr[ks][nt] = *(const bf16x8*)((ks < 2 ? VT : ST) + (16 * nt + l16) * 72 + 32 * (ks & 1) + 8 * lq);
        }
        __builtin_amdgcn_sched_barrier(0);
#pragma unroll
        for (int ks = 0; ks < 4; ++ks)
#pragma unroll
            for (int nt = 0; nt < 4; ++nt) acc[nt] = mfma16(afr[ks], bfr[ks][nt], acc[nt]);
    }
    if (d == 1) {
#pragma unroll
        for (int nt = 0; nt < 4; ++nt)
#pragma unroll
            for (int j = 0; j < 4; ++j) OX[(16 * mt + 4 * lq + j) * 68 + 16 * nt + l16] = acc[nt][j];
    }
    __syncthreads();
    if (d == 0) {
#pragma unroll
        for (int j = 0; j < 4; ++j) {
            const int i = 16 * mt + 4 * lq + j;
            float s = 0.f;
#pragma unroll
            for (int nt = 0; nt < 4; ++nt) { acc[nt][j] += OX[i * 68 + 16 * nt + l16]; s += acc[nt][j] * acc[nt][j]; }
            s += shx(s, 1, lane); s += shx(s, 2, lane); s += shx(s, 4, lane); s += shx(s, 8, lane);
            const float rstd = 1.f / sqrtf(s * (1.f / 64.f) + LN_EPS);
#pragma unroll
            for (int nt = 0; nt < 4; ++nt) {
                const int dv = 16 * nt + l16;
                const float gate = bf2f((unsigned short)gx[j][nt]);
                ((bf16*)(lds + 8192))[i * 72 + dv] = (bf16)f2bf1(acc[nt][j] * rstd * a.in[20][l * 64 + dv] * siluf_(gate));
            }
        }
    }
    __syncthreads();
    { const int r = tid >> 3, c = tid & 7; *(v4u*)(Y + (size_t)(m0 + r) * D + 256 + h * 64 + c * 8) = *(const v4u*)(lds + 8192 + r * 144 + c * 16); }
    __syncthreads();
}
#endif
typedef short v4i16_t __attribute__((ext_vector_type(4)));
typedef LAS const char* lds_cptr;
__device__ __forceinline__ s16x4 vtr(lds_cptr p) { return __builtin_bit_cast(s16x4, __builtin_amdgcn_ds_read_tr16_b64_v4i16((LAS v4i16_t*)p)); }
__device__ __forceinline__ float half_swap_max(float m) { auto rr = __builtin_amdgcn_permlane32_swap(__float_as_uint(m), __float_as_uint(m), false, false); return fmaxf(__uint_as_float(rr[0]), __uint_as_float(rr[1])); }
__device__ __forceinline__ float half_swap_sum(float m) { auto rr = __builtin_amdgcn_permlane32_swap(__float_as_uint(m), __float_as_uint(m), false, false); return __uint_as_float(rr[0]) + __uint_as_float(rr[1]); }
constexpr int KST = 272, VST = 320, KBUFB = 64 * KST, VBUFB = 64 * VST, OXS = 132;

__device__ __forceinline__ void attn_item(const Args& a, unsigned char* lds, int l, bool sample, int b, int h, int qblk, float lam, float oscale, int tid, int lane, int wave) {
    const bf16* Z = (const bf16*)(a.ws + WS_UZ);
    bf16* Y = (bf16*)(a.ws + WS_H);
    const int mseq0 = sample ? MPR + b * 4096 : b * 256;
    const int nNew = sample ? 64 : 4, NT = sample ? 72 : 4;
    const bf16* ck = (const bf16*)(a.ws + WS_CK) + (size_t)(((b * 2 + l) * 4 + h) * 512) * 128;
    const bf16* cv = (const bf16*)(a.ws + WS_CV) + (size_t)(((b * 2 + l) * 4 + h) * 512) * 128;
    const int mp = wave >> 2, qs = wave & 3, q32 = lane & 31, hh = lane >> 5;
    const int mq = mseq0 + qblk * 128 + qs * 32 + q32;
    bf16x8 qf[4];
    { const bf16* qp = Z + (size_t)mq * NZ + ZC_DQ + h * 128 + mp * 64 + hh * 8;
#pragma unroll
      for (int s = 0; s < 4; ++s) qf[s] = *(const bf16x8*)(qp + 16 * s); }
    unsigned char* Kb0 = lds; unsigned char* Vb0 = lds + 2 * KBUFB;
    const int lrow = tid >> 4, lch = tid & 15;
    v4u kr[2], vr[2];
#define ATT_LOADX(dst, kt, zc, cbase) do { _Pragma("unroll") for (int i_ = 0; i_ < 2; ++i_) { const int row_ = lrow + 32 * i_; \
        if ((kt) < nNew) dst[i_] = *(const v4u*)(Z + (size_t)(mseq0 + (kt) * 64 + row_) * NZ + h * 128 + lch * 8 + (zc)); \
        else dst[i_] = *(const v4u*)((cbase) + (size_t)(((kt) - nNew) * 64 + row_) * 128 + lch * 8); } } while (0)
#define ATT_STOREK(buf) do { _Pragma("unroll") for (int i_ = 0; i_ < 2; ++i_) *(v4u*)(Kb0 + (buf) * KBUFB + (lrow + 32 * i_) * KST + lch * 16) = kr[i_]; } while (0)
#define ATT_STOREV(buf) do { _Pragma("unroll") for (int i_ = 0; i_ < 2; ++i_) *(v4u*)(Vb0 + (buf) * VBUFB + (lrow + 32 * i_) * VST + lch * 16) = vr[i_]; } while (0)
    ATT_LOADX(kr, 0, ZC_DK, ck); ATT_STOREK(0);
    __syncthreads();
    f32x16 O[4];
#pragma unroll
    for (int i = 0; i < 4; ++i)
#pragma unroll
        for (int r = 0; r < 16; ++r) O[i][r] = 0.f;
    float mref = 0.f, lrun = 0.f;
    f32x16 negm;
    { float z_; asm volatile("v_mov_b32 %0, 0" : "=v"(z_));
#pragma unroll
      for (int r = 0; r < 16; ++r) negm[r] = z_; }
    asm volatile("" : "+v"(negm));
    const int koff = q32 * KST + (mp * 64 + hh * 8) * 2;
    const int voff = (4 * hh + ((lane & 15) >> 2)) * VST + (16 * ((lane >> 4) & 1) + 4 * (lane & 3)) * 2;
    bf16x8 pk[4];
#pragma unroll
    for (int i = 0; i < 4; ++i) pk[i] = (bf16x8){0, 0, 0, 0, 0, 0, 0, 0};
    f32x16 st0, st1;
    float fsc = 1.f, ps = 0.f; bool resc = false;
#define ATT_QKDEC(kt_) do { const unsigned char* Kb = Kb0 + ((kt_) & 1) * KBUFB + koff; \
        bf16x8 ka_[4], kb_[4]; \
        _Pragma("unroll") for (int s = 0; s < 4; ++s) { ka_[s] = *(const bf16x8*)(Kb + s * 32); kb_[s] = *(const bf16x8*)(Kb + 32 * KST + s * 32); } \
        __builtin_amdgcn_sched_barrier(0);              \
        _Pragma("unroll") for (int s = 0; s < 4; ++s) { \
            if (s == 0) { st0 = __builtin_amdgcn_mfma_f32_32x32x16_bf16(ka_[s], qf[s], negm, 0, 0, 0); st1 = __builtin_amdgcn_mfma_f32_32x32x16_bf16(kb_[s], qf[s], negm, 0, 0, 0); } \
            else { st0 = __builtin_amdgcn_mfma_f32_32x32x16_bf16(ka_[s], qf[s], st0, 0, 0, 0); st1 = __builtin_amdgcn_mfma_f32_32x32x16_bf16(kb_[s], qf[s], st1, 0, 0, 0); } } \
        float mx = fmaxf(st0[0], st1[0]); \
        _Pragma("unroll") for (int r = 1; r < 16; ++r) mx = fmaxf(fmaxf(mx, st0[r]), st1[r]); \
        mx = half_swap_max(mx); \
        fsc = 1.f; resc = false; \
        if ((kt_) == 0 || __any(mx > 8.f)) {        \
            const float delta = (kt_) == 0 ? mx : fmaxf(mx, 0.f); \
            mref += delta; fsc = __builtin_amdgcn_exp2f(-delta); resc = true; \
            _Pragma("unroll") for (int r = 0; r < 16; ++r) { st0[r] -= delta; st1[r] -= delta; } \
            _Pragma("unroll") for (int r = 0; r < 16; ++r) negm[r] = -mref; \
            asm volatile("" : "+v"(negm)); \
        } } while (0)
#define ATT_EXPQ(S, r0) do { _Pragma("unroll") for (int r = 0; r < 8; ++r) { S[(r0) + r] = __builtin_amdgcn_exp2f(S[(r0) + r]); ps += S[(r0) + r]; } } while (0)
#define ATT_PVG(Vb_, ks) do { _Pragma("unroll") for (int blk = 0; blk < 4; ++blk) { \
            const s16x4 lo = vtr(Vb_ + ((ks) * 16) * VST + blk * 64), hi = vtr(Vb_ + ((ks) * 16 + 8) * VST + blk * 64); \
            const bf16x8 vf = (bf16x8){lo[0], lo[1], lo[2], lo[3], hi[0], hi[1], hi[2], hi[3]}; \
            O[blk] = __builtin_amdgcn_mfma_f32_32x32x16_bf16(vf, pk[ks], O[blk], 0, 0, 0); } } while (0)
#define ATT_FIN() do { lrun = lrun * fsc + ps; \
        if (resc) { _Pragma("unroll") for (int i = 0; i < 4; ++i) _Pragma("unroll") for (int r = 0; r < 16; ++r) O[i][r] *= fsc; } \
        pk[0] = __builtin_bit_cast(bf16x8, (v4u){pk2(st0[0], st0[1]), pk2(st0[2], st0[3]), pk2(st0[4], st0[5]), pk2(st0[6], st0[7])}); \
        pk[1] = __builtin_bit_cast(bf16x8, (v4u){pk2(st0[8], st0[9]), pk2(st0[10], st0[11]), pk2(st0[12], st0[13]), pk2(st0[14], st0[15])}); \
        pk[2] = __builtin_bit_cast(bf16x8, (v4u){pk2(st1[0], st1[1]), pk2(st1[2], st1[3]), pk2(st1[4], st1[5]), pk2(st1[6], st1[7])}); \
        pk[3] = __builtin_bit_cast(bf16x8, (v4u){pk2(st1[8], st1[9]), pk2(st1[10], st1[11]), pk2(st1[12], st1[13]), pk2(st1[14], st1[15])}); } while (0)
    ATT_LOADX(kr, 1, ZC_DK, ck); ATT_LOADX(vr, 0, ZC_DV, cv);
    ATT_QKDEC(0);
    ps = 0.f; ATT_EXPQ(st0, 0); ATT_EXPQ(st0, 8); ATT_EXPQ(st1, 0); ATT_EXPQ(st1, 8);
    ATT_FIN();
    ATT_STOREK(1); ATT_STOREV(0);
    __syncthreads();
    for (int kt = 1; kt < NT; ++kt) {
        if (kt + 1 < NT) ATT_LOADX(kr, kt + 1, ZC_DK, ck);
        ATT_LOADX(vr, kt, ZC_DV, cv);
        ATT_QKDEC(kt);
        { const lds_cptr Vb = (lds_cptr)(Vb0 + ((kt - 1) & 1) * VBUFB) + voff;
          ps = 0.f;
          s16x4 nlo[4], nhi[4];
#pragma unroll
          for (int f_ = 0; f_ < 4; ++f_) { nlo[f_] = vtr(Vb + f_ * 64); nhi[f_] = vtr(Vb + 8 * VST + f_ * 64); }
          __builtin_amdgcn_sched_barrier(0);
#pragma unroll
          for (int i_ = 0; i_ < 16; ++i_) {
              const int ks = i_ >> 2, blk = i_ & 3;
              const bf16x8 vf = (bf16x8){nlo[blk][0], nlo[blk][1], nlo[blk][2], nlo[blk][3], nhi[blk][0], nhi[blk][1], nhi[blk][2], nhi[blk][3]};
              O[blk] = __builtin_amdgcn_mfma_f32_32x32x16_bf16(vf, pk[ks], O[blk], 0, 0, 0);
              if (i_ < 12) { nlo[blk] = vtr(Vb + ((ks + 1) * 16) * VST + blk * 64); nhi[blk] = vtr(Vb + ((ks + 1) * 16 + 8) * VST + blk * 64); }
              if (i_ < 8) { float e0 = __builtin_amdgcn_exp2f(st0[2 * i_]), e1 = __builtin_amdgcn_exp2f(st0[2 * i_ + 1]); ps += e0 + e1;
                  asm volatile("" : "+v"(e0), "+v"(e1), "+v"(ps));
                  st0[2 * i_] = e0; st0[2 * i_ + 1] = e1; }
              else { float e0 = __builtin_amdgcn_exp2f(st1[2 * i_ - 16]), e1 = __builtin_amdgcn_exp2f(st1[2 * i_ - 15]); ps += e0 + e1;
                  asm volatile("" : "+v"(e0), "+v"(e1), "+v"(ps));
                  st1[2 * i_ - 16] = e0; st1[2 * i_ - 15] = e1; }
              __builtin_amdgcn_sched_barrier(0);
          } }
        ATT_FIN();
        if (kt + 1 < NT) ATT_STOREK((kt + 1) & 1);
        ATT_STOREV(kt & 1);
        __syncthreads();
    }
    { const lds_cptr Vb = (lds_cptr)(Vb0 + ((NT - 1) & 1) * VBUFB) + voff;
      ATT_PVG(Vb, 0); ATT_PVG(Vb, 1); ATT_PVG(Vb, 2); ATT_PVG(Vb, 3); }
    __syncthreads();
#undef ATT_QKDEC
#undef ATT_EXPQ
#undef ATT_PVG
#undef ATT_FIN
#undef ATT_LOADX
#undef ATT_STOREK
#undef ATT_STOREV
    const float inv = 1.f / half_swap_sum(lrun);
    float* Ox = (float*)lds;
    const int qrow = qs * 32 + q32;
    if (mp == 0) {
#pragma unroll
        for (int blk = 0; blk < 4; ++blk)
#pragma unroll
            for (int g = 0; g < 4; ++g) *(f32x4*)(Ox + qrow * OXS + blk * 32 + 8 * g + 4 * hh) = (f32x4){O[blk][4 * g] * inv, O[blk][4 * g + 1] * inv, O[blk][4 * g + 2] * inv, O[blk][4 * g + 3] * inv};
    }
    __syncthreads();
    if (mp == 1) {
        float ss = 0.f; const float li = lam * inv;
#pragma unroll
        for (int blk = 0; blk < 4; ++blk)
#pragma unroll
            for (int g = 0; g < 4; ++g) { const f32x4 o1 = *(const f32x4*)(Ox + qrow * OXS + blk * 32 + 8 * g + 4 * hh);
#pragma unroll
                for (int e = 0; e < 4; ++e) { const float o = o1[e] - li * O[blk][4 * g + e]; O[blk][4 * g + e] = o; ss += o * o; } }
        ss = half_swap_sum(ss);
        const float rs = oscale / sqrtf(ss * (1.f / 128.f) + LN_EPS);
        const float* gn = a.in[22] + l * 128;
#pragma unroll
        for (int blk = 0; blk < 4; ++blk)
#pragma unroll
            for (int g = 0; g < 4; ++g) { const int dv = blk * 32 + 8 * g + 4 * hh; const f32x4 gv = *(const f32x4*)(gn + dv);
                v2u w; w.x = pk2(O[blk][4 * g] * rs * gv[0], O[blk][4 * g + 1] * rs * gv[1]); w.y = pk2(O[blk][4 * g + 2] * rs * gv[2], O[blk][4 * g + 3] * rs * gv[3]);
                *(v2u*)(lds + 67584 + qrow * 272 + dv * 2) = w; }
    }
    __syncthreads();
    {
        const int mblk = mseq0 + qblk * 128;
#pragma unroll
        for (int i = 0; i < 4; ++i) { const int ch = tid + 512 * i, r = ch >> 4, c = ch & 15;
            *(v4u*)(Y + (size_t)(mblk + r) * D + 512 + h * 128 + c * 8) = *(const v4u*)(lds + 67584 + r * 272 + c * 16); }
    }
    __syncthreads();
}

__device__ __forceinline__ void phase_attn(const Args& a, unsigned char* lds, int l, int tid, int lane, int wave) {
    OPQ_IDS();
    const float* lp = a.in[21] + l * 256;
    const float s1 = wave_sum(lp[lane] * lp[64 + lane], lane), s2 = wave_sum(lp[128 + lane] * lp[192 + lane], lane);
    const float lam_init = 0.8f - 0.6f * expf(-0.3f * (float)l);
    const float lam = expf(s1) - expf(s2) + lam_init;
    for (int p = BID; p < 1024; p += NB) {
        const int pair = (p >> 8) * 8 + (p & 7), qblk = (p & 255) >> 3;
        attn_item(a, lds, l, true, pair >> 2, pair & 3, qblk, lam, 1.f - lam_init, tid, lane, wave);
    }
    for (int p = BID; p < 128; p += NB) {
        const int pair = p >> 1;
        attn_item(a, lds, l, false, pair >> 2, pair & 3, p & 1, lam, 1.f - lam_init, tid, lane, wave);
    }
}

#define XB_TMO      128
#define XB_XCNT(j)  (256  + 64 * (j))
#define XB_XSUB(j)  (1280 + 64 * (j))
#define XB_XGEN(j)  (2304 + 64 * (j))
#define XB_TOP      3328
#define XB_TOPGEN   3392
#define XCD_BAR_WORDS 3456
#define XB_SPIN_CAP (1u << 18)

__device__ __forceinline__ unsigned xb_ld(unsigned* p)              { return __hip_atomic_load(p, __ATOMIC_RELAXED, __HIP_MEMORY_SCOPE_AGENT); }
__device__ __forceinline__ unsigned xb_add(unsigned* p, unsigned v) { return __hip_atomic_fetch_add(p, v, __ATOMIC_RELAXED, __HIP_MEMORY_SCOPE_AGENT); }
__device__ __forceinline__ unsigned xb_xcc_id() { return (unsigned)__builtin_amdgcn_s_getreg((3 << 11) | 20) & 0xFu; }
#define XB_SPIN(cond, bar) do { unsigned _sp = 0; while (cond) { __builtin_amdgcn_s_sleep(1); \
    if ((++_sp & 255u) == 0u) { if (xb_ld(&(bar)[XB_TMO])) break; if (_sp > XB_SPIN_CAP) { atomicAdd(&(bar)[XB_TMO], 1u); break; } } } } while (0)

struct XcdBarrier {
    unsigned* bar; unsigned x;
    volatile LAS unsigned* st;
};

__device__ __forceinline__ XcdBarrier xcd_barrier_post(unsigned* bar, volatile LAS unsigned* st) {
    XcdBarrier b; b.bar = bar; b.x = xb_xcc_id(); b.st = st;
    if (threadIdx.x == 0) (void)xb_add(&bar[XB_XCNT(b.x)], 1u);
    return b;
}
__device__ __forceinline__ void xcd_barrier_complete(unsigned* bar, unsigned x, unsigned& nloc, unsigned& nx) {
    const unsigned G = gridDim.x * gridDim.y * gridDim.z;
    unsigned sum, cnt, mine, sp = 0u;
    for (;;) {
        sum = 0u; cnt = 0u; mine = 0u;
#pragma unroll
        for (unsigned j = 0; j < 16; ++j) { const unsigned c = xb_ld(&bar[XB_XCNT(j)]); sum += c; cnt += (c > 0u) ? 1u : 0u; mine = (j == x) ? c : mine; }
        if (sum == G) break;
        __builtin_amdgcn_s_sleep(1);
        if ((++sp & 255u) == 0u) { if (xb_ld(&bar[XB_TMO])) break; if (sp > XB_SPIN_CAP) { atomicAdd(&bar[XB_TMO], 1u); break; } }
    }
    nloc = mine > 0u ? mine : 1u; nx = cnt > 0u ? cnt : 1u;
}

__device__ __forceinline__ void xcd_barrier(const XcdBarrier& b) {
    asm volatile("s_waitcnt vmcnt(0)" ::: "memory");
    __syncthreads();
    if (threadIdx.x == 0) {
        unsigned* bar = b.bar;
        __builtin_amdgcn_s_waitcnt(0);
        unsigned nloc = b.st[0], nx = b.st[1];
        if (nloc == 0u) { xcd_barrier_complete(bar, b.x, nloc, nx); b.st[0] = nloc; b.st[1] = nx; }
        const unsigned old = xb_add(&bar[XB_XSUB(b.x)], 1u);
        const unsigned gen = old / nloc;
        if (old + 1u == (gen + 1u) * nloc) {
            __builtin_amdgcn_fence(__ATOMIC_RELEASE, "agent");
            asm volatile("s_waitcnt vmcnt(0)" ::: "memory");
            const unsigned og = xb_add(&bar[XB_TOP], 1u);
            const unsigned tg = og / nx;
            if (og + 1u == (tg + 1u) * nx) xb_add(&bar[XB_TOPGEN], 1u);
            else XB_SPIN(xb_ld(&bar[XB_TOPGEN]) == tg, bar);
            __builtin_amdgcn_fence(__ATOMIC_ACQUIRE, "agent");
            xb_add(&bar[XB_XGEN(b.x)], 1u);
            asm volatile("s_waitcnt vmcnt(0)" ::: "memory");
        } else {
            XB_SPIN(xb_ld(&bar[XB_XGEN(b.x)]) == gen, bar);
            __builtin_amdgcn_fence(__ATOMIC_ACQUIRE, "agent");
            asm volatile("s_waitcnt vmcnt(0)" ::: "memory");
        }
    }
    __syncthreads();
}

template <int PHMT>
__global__ void __launch_bounds__(512, 2) fwd_kernel_t(Args a_) {
#undef PHM
#define PHM PHMT
    extern __shared__ __attribute__((aligned(16))) unsigned char lds[];
    cg::grid_group grid = cg::this_grid();
    const int ph_lo = a_.ph_lo, ph_hi = a_.ph_hi, coop = a_.coop;
    volatile LAS unsigned* stw = (volatile LAS unsigned*)((LAS unsigned char*)lds + 131072 + 256);
    if (threadIdx.x < 2) stw[threadIdx.x] = 0u;
    __syncthreads();
    if (coop) (void)xcd_barrier_post((unsigned*)a_.ws, stw);
    for (int ph = ph_lo; ph < ph_hi; ++ph) {
        const __attribute__((address_space(4))) Args* ap = (const __attribute__((address_space(4))) Args*)__builtin_amdgcn_kernarg_segment_ptr();
        asm volatile("" : "+s"(ap));
        const Args& a = *(const Args*)ap;
        OPQ_IDS();
        int tid = threadIdx.x; asm volatile("" : "+v"(tid));
        const int lane = tid & 63, wave = __builtin_amdgcn_readfirstlane(tid >> 6);
        if (ph == 0) { for (int rep = 0; rep < ((PROBE & 64) ? 2 : 1); ++rep) if (PHM & 1) phase_prologue(a, lds, tid, lane, wave); }
        else if (ph == 25) { if (PHM & 2) phase_rowpass(a, 2, 5, 0, 0, lane, wave, false, NB == 256 ? KSPLIT : 0, 4, 1, 8, 0.5f); }
        else {
            const int l = (ph - 1) / 12, st = (ph - 1) % 12;
            if ((PHM & 2) && (st == 0 || st == 3 || st == 9)) {
                const int sub = st == 0 ? 0 : (st == 3 ? 1 : 2);
                const int psn = NB == 256 ? KSPLIT : 0;
                if (st == 0) phase_rowpass(a, l == 0 ? 0 : 1, (l - 1) * 3 + 2, l, 0, lane, wave, false, l == 0 ? 0 : psn, 1, 0, 8, 0.5f);
                else phase_rowpass(a, 1, l * 3 + sub - 1, l, sub, lane, wave, false, psn, l * 3 + sub - 2, l, sub == 1 ? 2 : 5, sub == 1 ? 0.5f : 1.f);
                if ((PROBE & 256) && (st != 0 || l == 1)) phase_rowpass(a, 1, st == 0 ? (l - 1) * 3 + 2 : l * 3 + sub - 1, l, sub, lane, wave, true);
            } else if ((PHM & 4) && (st == 1 || st == 2 || st == 4 || st == 8 || st == 10 || st == 11)) {
                const int kind = (st == 1 || st == 10) ? 0 : (st == 4 ? 2 : 1);
                const bf16* A = (st == 2 || st == 11) ? (const bf16*)(a.ws + WS_UZ) : (const bf16*)(a.ws + WS_H);
                const bf16* Bt = (const bf16*)(a.ws + WS_W) + (size_t)l * WL_ELEMS + (st == 1 ? W1I : st == 2 ? W1O : st == 4 ? WIN : st == 8 ? WOUT : st == 10 ? W2I : W2O);
                const int N = kind == 0 ? 2 * DFF : (kind == 2 ? NZ : D), K = (st == 2 || st == 11) ? DFF : D;
                pg8::Gemm g{A, Bt, M, N, K}; pg8::StaticOrder S; S.init(M, N, K, NB, (int)BID); if (kind == 1 && NB == 256) S.nsplit = KSPLIT;
                const int nrep = (((PROBE & 1) && kind == 0) || ((PROBE & 2) && kind == 2) || ((PROBE & 512) && kind == 1)) ? 2 : 1;
                for (int rep = 0; rep < nrep; ++rep) {
                    pg8::EpiAny E{a, (kind == 1 && rep == 1) ? 3 : kind, l, st == 2 ? 2 : (st == 8 ? 5 : 8), st == 8 ? 1.f : 0.5f, l * 3 + (st == 2 ? 0 : (st == 8 ? 1 : 2)) - 1};
                    pg8::gemm_phase<pg8::EpiAny, pg8::StaticOrder, true, true>((PG8_LAS unsigned char*)lds, g, S, E);
                }
            } else if ((PHM & 32) && st == 5) {
                for (int rep = 0; rep < ((PROBE & 4) ? 2 : 1); ++rep)
                    for (int it = BID; it < NTC * 4; it += NB) gla_g1_item(a, lds, l, it, tid);
            } else if ((PHM & 64) && st == 6) {
                gla_scan(a, l, tid);
                if (PROBE & 128) gla_scan(a, l, tid, (size_t)18874368);
                for (int rep = 0; rep < ((PROBE & 8) ? 2 : 1); ++rep)
                    for (int tc = BID; tc < NTC; tc += NB) conv_item(a, lds, l, tc, tid, lane, wave);
            } else if (st == 7) {
                for (int rep = 0; rep < ((PROBE & 16) ? 2 : 1); ++rep)
                    if (PHM & 128) phase_attn(a, lds, l, tid, lane, wave);
                for (int rep = 0; rep < ((PROBE & 32) ? 2 : 1); ++rep)
                    if (PHM & 256) for (int it = BID; it < NTC * 4; it += NB) gla_g3_item(a, lds, l, it, tid);
            }
        }
        if (coop && ph + 1 < ph_hi) {
            if (ph == 0 || !FAST_BAR) grid.sync();
            else { XcdBarrier xb; xb.bar = (unsigned*)a.ws; xb.x = xb_xcc_id(); xb.st = stw; xcd_barrier(xb); if (PROBE & 1024) { xcd_barrier(xb); xcd_barrier(xb); } }
        }
    }
}

#undef PHM
#if MK_PER_PHASE
static int phase_mask(int ph) {
    if (ph == 0) return 1; if (ph == 25) return 2;
    const int st = (ph - 1) % 12;
    if (st == 0 || st == 3 || st == 9) return 2;
    if (st == 5) return 32; if (st == 6) return 64; if (st == 7) return 128 | 256;
    return 4;
}
#define KFN(m) ((const void*)fwd_kernel_t<m>)
#else
#define KFN(m) ((const void*)fwd_kernel_t<0xFFFF>)
#endif
extern "C" void kernel_launch(void* const* d_in, const int* in_sizes, int n_in, void* d_out, int out_size, void* d_ws, size_t ws_size, hipStream_t stream) {
    static int grid = 0;
    if (grid == 0) {
        if (n_in != 26 || ws_size < WS_END) { fprintf(stderr, "kernel_launch: unexpected n_in %d / ws_size %zu (need %zu)\n", n_in, ws_size, (size_t)WS_END); grid = -1; return; }
        int dev = 0, cus = 0;
        (void)hipGetDevice(&dev); (void)hipDeviceGetAttribute(&cus, hipDeviceAttributeMultiprocessorCount, dev);
#if MK_PER_PHASE
        const void* fns[6] = {KFN(1), KFN(2), KFN(4), KFN(32), KFN(64), KFN(384)};
        for (int i = 0; i < 6; ++i) if (hipFuncSetAttribute(fns[i], hipFuncAttributeMaxDynamicSharedMemorySize, LDS_BYTES) != hipSuccess) { fprintf(stderr, "kernel_launch: hipFuncSetAttribute failed\n"); grid = -1; return; }
#else
        if (hipFuncSetAttribute(KFN(0), hipFuncAttributeMaxDynamicSharedMemorySize, LDS_BYTES) != hipSuccess) { fprintf(stderr, "kernel_launch: hipFuncSetAttribute failed\n"); grid = -1; return; }
        int per_cu = 0;
        if (hipOccupancyMaxActiveBlocksPerMultiprocessor(&per_cu, KFN(0), 512, LDS_BYTES) != hipSuccess || per_cu < 1) fprintf(stderr, "kernel_launch: occupancy query gave %d\n", per_cu);
#endif
        (void)hipGetLastError();
        grid = cus > 0 ? cus : 256;
    }
    if (grid < 0) return;
    Args a{};
    for (int i = 0; i < 26; ++i) a.in[i] = (const float*)d_in[i];
    a.out = (float*)d_out; a.ws = (unsigned char*)d_ws; a.pad = 0;
#if MK_PER_PHASE
    for (int ph = 0; ph < 26; ++ph) {
        a.ph_lo = ph; a.ph_hi = ph + 1; a.coop = 0;
        void* args[] = {&a};
        const int m = phase_mask(ph);
        const void* fn = m == 1 ? KFN(1) : m == 2 ? KFN(2) : m == 4 ? KFN(4) : m == 32 ? KFN(32) : m == 64 ? KFN(64) : KFN(384);
        hipError_t e = hipLaunchKernel(fn, dim3(grid), dim3(512), args, LDS_BYTES, stream);
        if (e != hipSuccess) { fprintf(stderr, "launch %d failed: %s\n", ph, hipGetErrorString(e)); break; }
    }
#else
    a.ph_lo = 0; a.ph_hi = 26; a.coop = 1;
    (void)hipMemsetAsync(d_ws, 0, 16384, stream);
    void* args[] = {&a};
    hipError_t e = hipLaunchCooperativeKernel(KFN(0), dim3(grid), dim3(512), args, LDS_BYTES, stream);
    if (e != hipSuccess) fprintf(stderr, "cooperative launch failed: %s (grid %d)\n", hipGetErrorString(e), grid);
#endif
}
```
